# Optimizing an MI355X kernel written in HIP

```python
import jax, jax.numpy as jnp
from jax import lax
import numpy as np

D_MODEL = 2048
BATCH = 2
SEQ = 16384
DEPTH = 4

CHUNK = 64
N_META = 16
D_A = 1024
CONV_WIDTH = 3
D_B = 2048
HEAD_SIZE = 64
N_HEADS_B = D_B // HEAD_SIZE
DECAY_LORA = 96
ICLR_LORA = 96
COLS_A = 4 * D_A
COLS_B = 4 * D_B + DECAY_LORA + ICLR_LORA
COLS_G = 2 * D_MODEL
N_COLS = COLS_A + COLS_B + COLS_G
LN_EPS = 1e-5
GN_EPS = 6.4e-4

kernel_name = "hybrid_shortconv_rwkv7_gated_deepnorm"


def _layer_norm(x, g, b):
    xf = x.astype(jnp.float32)
    mu = jnp.mean(xf, axis=-1, keepdims=True)
    var = jnp.mean(jnp.square(xf - mu), axis=-1, keepdims=True)
    return ((xf - mu) * lax.rsqrt(var + LN_EPS) * g + b).astype(x.dtype)


def _shift(p):
    return jnp.pad(p[:, :-1], ((0, 0), (1, 0), (0, 0)))


def _short_conv(h, w):
    t = h.shape[1]
    hp = jnp.pad(h, ((0, 0), (CONV_WIDTH - 1, 0), (0, 0)))
    return sum(hp[:, j:j + t] * w[j] for j in range(CONV_WIDTH))


def _conv_branch(pa, conv_w):
    xin, b_gate, c_gate, z = jnp.split(pa, 4, axis=-1)
    y = b_gate * _short_conv(c_gate * xin, conv_w)
    return y * jax.nn.silu(z)


def _rwkv_step(state, inp):
    r, w, k, v, kk, kka = inp
    sa = jnp.einsum('bhvk,bhk->bhv', state, kk)
    state = (state * w[:, :, None, :] - sa[..., None] * kka[:, :, None, :]
             + v[..., None] * k[:, :, None, :])
    y = jnp.einsum('bhvk,bhk->bhv', state, r)
    return state, y


def _rwkv_scan(r, w, k, v, kk, kka):
    seq = tuple(jnp.moveaxis(t, 1, 0) for t in (r, w, k, v, kk, kka))
    bsz = r.shape[0]
    s0 = jnp.zeros((bsz, N_HEADS_B, HEAD_SIZE, HEAD_SIZE), r.dtype)
    s1, y_meta = lax.scan(_rwkv_step, s0, tuple(t[:N_META] for t in seq))
    frames = tuple(t[N_META:].reshape((-1, CHUNK) + t.shape[1:]) for t in seq)

    def chunk_step(state, chunk):
        return lax.scan(_rwkv_step, state, chunk)

    _, y_frames = lax.scan(chunk_step, s1, frames)
    y = jnp.concatenate([y_meta, y_frames.reshape((-1,) + y_meta.shape[1:])], axis=0)
    return jnp.moveaxis(y, 0, 1)


def _rwkv_branch(pb, mu, w0, w2, a0, a2, k_kk, k_a, r_k, gn_g, gn_b):
    pb = pb + mu * (_shift(pb) - pb)
    r, k, v, z, w_lo, a_lo = jnp.split(
        pb, [D_B, 2 * D_B, 3 * D_B, 4 * D_B, 4 * D_B + DECAY_LORA], axis=-1)
    w_log = -jax.nn.softplus(-(w0 + jnp.tanh(w_lo) @ w2)) - 0.5
    decay = jnp.exp(-jnp.exp(w_log))
    a = jax.nn.sigmoid(a0 + a_lo @ a2)
    bsz, t, _ = pb.shape
    heads = lambda u: u.reshape(bsz, t, N_HEADS_B, HEAD_SIZE)
    kk = heads(k * k_kk)
    kk = kk / jnp.maximum(jnp.linalg.norm(kk, axis=-1, keepdims=True), 1e-12)
    k = k * (1.0 + (a - 1.0) * k_a)
    r, decay, k, v, a = heads(r), heads(decay), heads(k), heads(v), heads(a)
    y = _rwkv_scan(r, decay, k, v, kk, kk * a)
    yf = y.astype(jnp.float32)
    m = jnp.mean(yf, axis=-1, keepdims=True)
    var = jnp.mean(jnp.square(yf - m), axis=-1, keepdims=True)
    y_n = ((yf - m) * lax.rsqrt(var + GN_EPS)).astype(y.dtype)
    y_n = y_n * gn_g.reshape(N_HEADS_B, HEAD_SIZE) + gn_b.reshape(N_HEADS_B, HEAD_SIZE)
    bonus = jnp.sum(r * k * r_k, axis=-1, keepdims=True) * v
    return (y_n + bonus).reshape(bsz, t, D_B) * jax.nn.silu(z)


def setup_inputs(seed: int = 0) -> dict:
    key = jax.random.key(seed)
    ks = jax.random.split(key, 21)
    beta = (8.0 * DEPTH) ** -0.25

    def nrm(k, shape, scale):
        return jax.random.normal(k, shape, jnp.float32) * scale

    return {
        "x": nrm(ks[0], (BATCH, SEQ, D_MODEL), 1.0),
        "meta_tokens": nrm(ks[1], (N_META, D_MODEL), 1.0),
        "emb_ln_g": 1.0 + nrm(ks[2], (D_MODEL,), 0.02),
        "emb_ln_b": nrm(ks[3], (D_MODEL,), 0.02),
        "w_in": nrm(ks[4], (DEPTH, D_MODEL, N_COLS), D_MODEL ** -0.5),
        "conv_w": nrm(ks[5], (DEPTH, CONV_WIDTH, D_A), CONV_WIDTH ** -0.5),
        "w_branch_a": nrm(ks[6], (DEPTH, D_A, D_MODEL), beta * D_A ** -0.5),
        "rwkv_mu": jax.random.uniform(ks[7], (DEPTH, COLS_B), jnp.float32),
        "decay_w0": jax.random.uniform(ks[8], (DEPTH, D_B), jnp.float32, minval=-6.0, maxval=1.0),
        "decay_w2": nrm(ks[9], (DEPTH, DECAY_LORA, D_B), 0.1 * DECAY_LORA ** -0.5),
        "iclr_a0": nrm(ks[10], (DEPTH, D_B), 0.1),
        "iclr_a2": nrm(ks[11], (DEPTH, ICLR_LORA, D_B), ICLR_LORA ** -0.5),
        "key_kk_scale": 0.85 + nrm(ks[12], (DEPTH, D_B), 0.02),
        "key_a_scale": 1.0 + nrm(ks[13], (DEPTH, D_B), 0.02),
        "bonus_rk": nrm(ks[14], (DEPTH, N_HEADS_B, HEAD_SIZE), 0.1),
        "gn_g": 1.0 + nrm(ks[15], (DEPTH, D_B), 0.02),
        "gn_b": nrm(ks[16], (DEPTH, D_B), 0.02),
        "w_branch_b": nrm(ks[17], (DEPTH, D_B, D_MODEL), beta * D_B ** -0.5),
        "w_out": nrm(ks[18], (DEPTH, D_MODEL, D_MODEL), beta * D_MODEL ** -0.5),
        "ln_g": 1.0 + nrm(ks[19], (DEPTH, D_MODEL), 0.02),
        "ln_b": nrm(ks[20], (DEPTH, D_MODEL), 0.02),
    }


def reference(x, meta_tokens, emb_ln_g, emb_ln_b, w_in, conv_w, w_branch_a, rwkv_mu,
              decay_w0, decay_w2, iclr_a0, iclr_a2, key_kk_scale, key_a_scale, bonus_rk,
              gn_g, gn_b, w_branch_b, w_out, ln_g, ln_b):
    bsz = x.shape[0]
    meta = jnp.broadcast_to(meta_tokens[None].astype(x.dtype), (bsz, N_META, D_MODEL))
    h = jnp.concatenate([meta, x], axis=1)
    h = _layer_norm(h, emb_ln_g, emb_ln_b)
    alpha = (2.0 * DEPTH) ** 0.25
    for l in range(DEPTH):
        p = h @ w_in[l]
        pa, pb, pg = jnp.split(p, [COLS_A, COLS_A + COLS_B], axis=-1)
        y_a = _conv_branch(pa, conv_w[l]) @ w_branch_a[l]
        y_b = _rwkv_branch(pb, rwkv_mu[l], decay_w0[l], decay_w2[l], iclr_a0[l],
                           iclr_a2[l], key_kk_scale[l], key_a_scale[l], bonus_rk[l],
                           gn_g[l], gn_b[l]) @ w_branch_b[l]
        g_a, g_b = jnp.split(jax.nn.sigmoid(pg), 2, axis=-1)
        out = (g_a * y_a + g_b * y_b) @ w_out[l]
        h = _layer_norm(alpha * h + out, ln_g[l], ln_b[l])
    return h[:, N_META:]
```

```cpp
#include <hip/hip_runtime.h>
#include <hip/hip_cooperative_groups.h>
#include <cstdio>
#include <cstdint>
namespace cg = cooperative_groups;

#define LAS __attribute__((address_space(3)))
typedef unsigned short bf16_t;
typedef short bf16x8 __attribute__((ext_vector_type(8)));
typedef float f32x4 __attribute__((ext_vector_type(4)));
typedef float f32x2 __attribute__((ext_vector_type(2)));
typedef unsigned u32x4 __attribute__((ext_vector_type(4)));
typedef unsigned u32x2 __attribute__((ext_vector_type(2)));
typedef _Float16 h16x2 __attribute__((ext_vector_type(2)));

constexpr int D = 2048, SEQ = 16384, NBATCH = 2, DEPTH = 4;
constexpr int NREAL = NBATCH * SEQ;
constexpr int NMETA = 16;
constexpr int NROWS = NREAL + NMETA;
constexpr int MPAD = 33024;
constexpr int NCOLS = 16576, NP = 16640;
constexpr int DA = 1024, DB = 2048, NHEAD = 32, LORA = 96;
constexpr int PC_XIN = 0, PC_BG = 1024, PC_CG = 2048, PC_ZA = 3072, PC_R = 4096, PC_K = 6144, PC_V = 8192, PC_Z = 10240,
              PC_GA = 12288, PC_GB = 14336, PC_WLO = 16384, PC_ALO = 16480;
constexpr float LN_EPS = 1e-5f, GN_EPS = 6.4e-4f;
constexpr float ALPHA = 1.6817928305074292f;

constexpr size_t al256(size_t x) { return (x + 255) & ~(size_t)255; }
constexpr size_t WS_WIN = 0;
constexpr size_t WS_WA = al256(WS_WIN + (size_t)NP * D * 2);
constexpr size_t WS_WB = al256(WS_WA + (size_t)DEPTH * D * DA * 2);
constexpr size_t WS_WO = al256(WS_WB + (size_t)DEPTH * D * DB * 2);
constexpr size_t WS_WL = al256(WS_WO + (size_t)DEPTH * D * D * 2);
constexpr size_t WS_HF = al256(WS_WL + (size_t)DEPTH * 4096 * 256 * 2);
constexpr size_t WS_HB = al256(WS_HF + (size_t)MPAD * D * 4);
constexpr size_t WS_P = al256(WS_HB + (size_t)MPAD * D * 2);
constexpr size_t WS_CO = al256(WS_P + (size_t)MPAD * NP * 2);
constexpr size_t WS_SB = al256(WS_CO + (size_t)MPAD * DA * 2);
constexpr size_t WS_AB = al256(WS_SB + (size_t)MPAD * DB * 2);
constexpr size_t WS_AL = al256(WS_AB + (size_t)MPAD * DB * 2);
constexpr size_t WS_BON = al256(WS_AL + (size_t)MPAD * 256 * 2);
constexpr size_t WS_END = al256(WS_BON + (size_t)MPAD * 32 * 4);

struct Params {
    const float *x, *meta, *emb_g, *emb_b, *w_in, *conv_w, *w_a, *mu, *w0, *w2, *a0, *a2, *kks, *kas, *rk, *gn_g, *gn_b, *w_b, *w_out, *ln_g, *ln_b;
    float* out; unsigned char* ws;
};

__device__ __forceinline__ unsigned cvt_pk_bf16(float lo, float hi) { unsigned r; asm volatile("v_cvt_pk_bf16_f32 %0, %1, %2" : "=v"(r) : "v"(lo), "v"(hi)); return r; }
__device__ __forceinline__ float bf_lo(unsigned w) { return __uint_as_float(w << 16); }
__device__ __forceinline__ float bf_hi(unsigned w) { return __uint_as_float(w & 0xffff0000u); }
__device__ __forceinline__ void unpack8(const u32x4 w, float (&f)[8]) {
    f[0] = bf_lo(w.x); f[1] = bf_hi(w.x); f[2] = bf_lo(w.y); f[3] = bf_hi(w.y); f[4] = bf_lo(w.z); f[5] = bf_hi(w.z); f[6] = bf_lo(w.w); f[7] = bf_hi(w.w);
}
__device__ __forceinline__ u32x4 pack8(const float (&f)[8]) {
    u32x4 w; w.x = cvt_pk_bf16(f[0], f[1]); w.y = cvt_pk_bf16(f[2], f[3]); w.z = cvt_pk_bf16(f[4], f[5]); w.w = cvt_pk_bf16(f[6], f[7]); return w;
}
__device__ __forceinline__ unsigned pack_h2(float a, float b) { h16x2 v; v.x = (_Float16)a; v.y = (_Float16)b; return __builtin_bit_cast(unsigned, v); }
__device__ __forceinline__ float h_lo(unsigned w) { return (float)__builtin_bit_cast(_Float16, (unsigned short)(w & 0xffffu)); }
__device__ __forceinline__ float h_hi(unsigned w) { return (float)__builtin_bit_cast(_Float16, (unsigned short)(w >> 16)); }
__device__ __forceinline__ void unpack8h(const u32x4 w, float (&f)[8]) {
    f[0] = h_lo(w.x); f[1] = h_hi(w.x); f[2] = h_lo(w.y); f[3] = h_hi(w.y); f[4] = h_lo(w.z); f[5] = h_hi(w.z); f[6] = h_lo(w.w); f[7] = h_hi(w.w);
}
__device__ __forceinline__ float sigmoidf_(float v) { return __builtin_amdgcn_rcpf(1.0f + __expf(-v)); }
__device__ __forceinline__ float siluf_(float v) { return v * sigmoidf_(v); }
template <int CTRL> __device__ __forceinline__ float dpp_mov(float x) {
    return __builtin_bit_cast(float, __builtin_amdgcn_mov_dpp(__builtin_bit_cast(int, x), CTRL, 0xf, 0xf, true));
}
__device__ __forceinline__ float allred8(float x) { x += dpp_mov<0xB1>(x); x += dpp_mov<0x4E>(x); x += dpp_mov<0x141>(x); return x; }
__device__ __forceinline__ float allred16(float x) { x = allred8(x); x += dpp_mov<0x128>(x); return x; }
__device__ __forceinline__ float wave_sum(float v) {
#pragma unroll
    for (int o = 1; o < 64; o <<= 1) v += __shfl_xor(v, o);
    return v;
}
__device__ __forceinline__ int prev_row(int r) { if (r >= NREAL) return r == NREAL ? -1 : r - 1; return (r & (SEQ - 1)) ? r - 1 : NROWS - 1; }

#ifndef GEMM_SP2
#define GEMM_SP2 true
#endif
#ifndef GEMM_ALIGN
#define GEMM_ALIGN true
#endif
namespace pg8 {
constexpr int BM = 256, BK = 64, HALF = 128, HTB = HALF * BK * 2, STAGE_BYTES = 8 * HTB, NXCD = 8, WGM = 4;
__host__ __device__ __forceinline__ int lds_byte(int r, int c) { const int st = (r >> 4) * 2 + (c >> 5), rr = r & 15, cc = c & 31, ob = rr * 64 + cc * 2; return st * 1024 + (ob ^ (((ob >> 9) & 1) << 5)); }
__host__ __device__ __forceinline__ void stage_rc(int b, int& R, int& C) { const int st = b / 1024, sb = b % 1024, swz = sb ^ (((sb >> 9) & 1) << 5); R = (st >> 1) * 16 + swz / 64; C = (st & 1) * 32 + (swz % 64) / 2; }
__host__ __device__ __forceinline__ int perm32(int rho) { const int n = rho >> 4, i = rho & 15; return 8 * (i >> 2) + 4 * n + (i & 3); }
struct Unit { int pm, pn; };
struct Gemm { const bf16_t* A; const bf16_t* Bt; int M, N, K; };
struct StaticOrder {
    int nM, nN, nwg, G, c;
    __device__ void init(int M, int N, int G_, int c_) { nM = M / BM; nN = N / BM; nwg = nM * nN; G = G_; c = c_; }
    __device__ bool next(int i, Unit& u) const {
        const long L = (long)i * G + c; if (L >= nwg) return false;
        int wgid = (int)L; { const int q = nwg / NXCD, r = nwg % NXCD, xcd = wgid % NXCD, off = wgid / NXCD; wgid = (xcd < r ? xcd * (q + 1) : r * (q + 1) + (xcd - r) * q) + off; }
        const int nig = WGM * nN, gid = wgid / nig, fm = gid * WGM, gsz = (nM - fm) < WGM ? (nM - fm) : WGM;
        u.pm = fm + ((wgid % nig) % gsz); u.pn = (wgid % nig) / gsz; return true;
    }
    __device__ __forceinline__ void a_ready(const Unit&) const {}
    __device__ __forceinline__ void done(const Unit&) const {}
};

template <class Epi, class Sched, bool ALIGN_EPI = false, bool SP2 = false>
__device__ __forceinline__ void gemm_phase(LAS unsigned char* lds, const Gemm g, const Sched& S, const Epi& E, const int tid) {
    const int wid = __builtin_amdgcn_readfirstlane(tid >> 6), lane = tid & 63, wr = wid >> 2, wc = wid & 3, fr = lane & 15, fq = lane >> 4;
    int K = g.K; asm volatile("" : "+s"(K)); const int nt = K / BK;
    unsigned voffA[2], voffB[2];
#pragma unroll
    for (int i = 0; i < 2; ++i) { int R, C; stage_rc(tid * 16 + i * 8192, R, C); const int Rb = Epi::PERM ? ((R & ~31) + perm32(R & 31)) : R;
        voffA[i] = (unsigned)(R * K + C) * 2u; voffB[i] = (unsigned)(Rb * K + C) * 2u; }
    const size_t kstep = (size_t)(BK * 2);
    const size_t hstep = (size_t)HALF * K * 2;
    const size_t tstep = 2 * hstep;
    const unsigned ldsw = (unsigned)wid * 1024u;
    const int aoff = lds_byte(wr * 64 + fr, fq * 8), boff = lds_byte(wc * 32 + fr, fq * 8);
#define PG8_SA(b, h) (((b) * 2 + (h)) * HTB)
#define PG8_SB(b, h) ((4 + (b) * 2 + (h)) * HTB)
#define PG8_STAGE(bufoff, gbase, voff) do { _Pragma("unroll") for (int _i = 0; _i < 2; ++_i) \
        __builtin_amdgcn_global_load_lds((const unsigned*)((const char*)(gbase) + (voff)[_i]), (LAS unsigned*)(lds + (bufoff) + ldsw + _i * 8192), 16, 0, 0); } while (0)
#define PG8_LDA(dst, b, h) do { _Pragma("unroll") for (int m = 0; m < 4; ++m) _Pragma("unroll") for (int k = 0; k < 2; ++k) dst[m][k] = *(const LAS bf16x8*)(lds + PG8_SA(b, h) + aoff + m * 2048 + k * 1024); } while (0)
#define PG8_LDB(dst, b, h) do { _Pragma("unroll") for (int n = 0; n < 2; ++n) _Pragma("unroll") for (int k = 0; k < 2; ++k) dst[n][k] = *(const LAS bf16x8*)(lds + PG8_SB(b, h) + boff + n * 2048 + k * 1024); } while (0)
#define PG8_MMA(ai, bj, At, Bt) do { __builtin_amdgcn_s_setprio(1); _Pragma("unroll") for (int m = 0; m < 4; ++m) _Pragma("unroll") for (int n = 0; n < 2; ++n) _Pragma("unroll") for (int k = 0; k < 2; ++k) \
        acc[ai][bj][m][n] = __builtin_amdgcn_mfma_f32_16x16x32_bf16(Bt[n][k], At[m][k], acc[ai][bj][m][n], 0, 0, 0); __builtin_amdgcn_s_setprio(0); } while (0)
#define PG8_WAIT_V(n) asm volatile("s_waitcnt vmcnt(" #n ")" ::: "memory")
#define PG8_WAIT_L(n) asm volatile("s_waitcnt lgkmcnt(" #n ")" ::: "memory")
#define PG8_BAR __builtin_amdgcn_s_barrier()
#define PG8_SCHED __builtin_amdgcn_sched_barrier(0)
    Unit cur, nxt; int ui = 0;
    if (!S.next(0, cur)) return;
    f32x4 acc[2][2][4][2];
#pragma unroll
    for (int a = 0; a < 2; ++a)
#pragma unroll
        for (int b = 0; b < 2; ++b)
#pragma unroll
            for (int m = 0; m < 4; ++m)
#pragma unroll
                for (int n = 0; n < 2; ++n) acc[a][b][m][n] = (f32x4){0.f, 0.f, 0.f, 0.f};
    bf16x8 At[4][2], B0[2][2], B1[2][2];
    const char* cA = (const char*)g.A + (size_t)cur.pm * tstep; const char* cB = (const char*)g.Bt + (size_t)cur.pn * tstep;
    S.a_ready(cur);
    if constexpr (SP2) {
        PG8_STAGE(PG8_SB(0, 0), cB, voffB); PG8_STAGE(PG8_SB(0, 1), cB + hstep, voffB); PG8_STAGE(PG8_SA(0, 0), cA, voffA); PG8_STAGE(PG8_SA(0, 1), cA + hstep, voffA);
        if (wr == 1) PG8_BAR;
        PG8_WAIT_V(2); PG8_BAR;
        PG8_STAGE(PG8_SB(1, 0), cB + kstep, voffB); PG8_STAGE(PG8_SA(1, 0), cA + kstep, voffA); PG8_STAGE(PG8_SB(1, 1), cB + hstep + kstep, voffB);
        PG8_WAIT_V(6); PG8_BAR;
    } else {
        PG8_STAGE(PG8_SB(0, 0), cB, voffB); PG8_STAGE(PG8_SA(0, 0), cA, voffA); PG8_STAGE(PG8_SB(0, 1), cB + hstep, voffB); PG8_STAGE(PG8_SA(0, 1), cA + hstep, voffA);
        if (wr == 1) PG8_BAR;
        PG8_WAIT_V(4); PG8_BAR;
        PG8_STAGE(PG8_SB(1, 0), cB + kstep, voffB); PG8_STAGE(PG8_SA(1, 0), cA + kstep, voffA); PG8_STAGE(PG8_SB(1, 1), cB + hstep + kstep, voffB);
        PG8_WAIT_V(6); PG8_BAR;
    }
    for (;;) {
        const bool has_next = S.next(ui + 1, nxt);
        const char* nA = has_next ? (const char*)g.A + (size_t)nxt.pm * tstep : cA; const char* nB = has_next ? (const char*)g.Bt + (size_t)nxt.pn * tstep : cB;
        for (int t = 0; t < nt; t += 2) {
            const bool last = (t == nt - 2);
            const char* a1 = cA + (size_t)(t + 1) * kstep;
            const char* a2 = last ? nA : cA + (size_t)(t + 2) * kstep; const char* b2 = last ? nB : cB + (size_t)(t + 2) * kstep;
            const char* a3 = a2 + kstep; const char* b3 = b2 + kstep;
            if (last && has_next) S.a_ready(nxt);
            if constexpr (SP2) {
            PG8_LDB(B0, 0, 0); PG8_LDB(B1, 0, 1); PG8_SCHED; PG8_LDA(At, 0, 0); PG8_STAGE(PG8_SA(1, 1), a1 + hstep, voffA);
            PG8_WAIT_V(8); PG8_WAIT_L(0); PG8_BAR; PG8_MMA(0, 0, At, B0); PG8_MMA(0, 1, At, B1); PG8_BAR; PG8_SCHED;
            PG8_LDA(At, 0, 1); PG8_STAGE(PG8_SB(0, 0), b2, voffB); PG8_STAGE(PG8_SB(0, 1), b2 + hstep, voffB); PG8_STAGE(PG8_SA(0, 0), a2, voffA);
            PG8_WAIT_V(8); PG8_WAIT_L(0); PG8_BAR; PG8_MMA(1, 0, At, B0); PG8_MMA(1, 1, At, B1); PG8_BAR; PG8_SCHED;
            PG8_LDB(B0, 1, 0); PG8_LDB(B1, 1, 1); PG8_SCHED; PG8_LDA(At, 1, 0); PG8_STAGE(PG8_SA(0, 1), a2 + hstep, voffA);
            PG8_WAIT_V(8); PG8_WAIT_L(0); PG8_BAR; PG8_MMA(0, 0, At, B0); PG8_MMA(0, 1, At, B1); PG8_BAR; PG8_SCHED;
            PG8_LDA(At, 1, 1); PG8_STAGE(PG8_SB(1, 0), b3, voffB); PG8_STAGE(PG8_SB(1, 1), b3 + hstep, voffB); PG8_STAGE(PG8_SA(1, 0), a3, voffA);
            PG8_WAIT_V(8); PG8_WAIT_L(0); PG8_BAR; PG8_MMA(1, 0, At, B0); PG8_MMA(1, 1, At, B1); PG8_BAR; PG8_SCHED;
            } else {
            PG8_LDB(B0, 0, 0); PG8_SCHED; PG8_LDA(At, 0, 0); PG8_STAGE(PG8_SA(1, 1), a1 + hstep, voffA);
            PG8_WAIT_L(8); PG8_BAR; PG8_WAIT_L(0); PG8_MMA(0, 0, At, B0); PG8_BAR; PG8_SCHED;
            PG8_LDB(B1, 0, 1); PG8_STAGE(PG8_SB(0, 0), b2, voffB);
            PG8_BAR; PG8_WAIT_L(0); PG8_MMA(0, 1, At, B1); PG8_BAR;
            PG8_LDA(At, 0, 1); PG8_STAGE(PG8_SA(0, 0), a2, voffA);
            PG8_BAR; PG8_WAIT_L(0); PG8_MMA(1, 0, At, B0); PG8_BAR; PG8_SCHED;
            PG8_STAGE(PG8_SB(0, 1), b2 + hstep, voffB);
            PG8_WAIT_V(6); PG8_BAR; PG8_MMA(1, 1, At, B1); PG8_BAR;
            PG8_LDB(B0, 1, 0); PG8_SCHED; PG8_LDA(At, 1, 0); PG8_STAGE(PG8_SA(0, 1), a2 + hstep, voffA);
            PG8_WAIT_L(8); PG8_BAR; PG8_WAIT_L(0); PG8_MMA(0, 0, At, B0); PG8_BAR; PG8_SCHED;
            PG8_LDB(B1, 1, 1); PG8_STAGE(PG8_SB(1, 0), b3, voffB);
            PG8_BAR; PG8_WAIT_L(0); PG8_MMA(0, 1, At, B1); PG8_BAR;
            PG8_LDA(At, 1, 1); PG8_STAGE(PG8_SA(1, 0), a3, voffA);
            PG8_BAR; PG8_WAIT_L(0); PG8_MMA(1, 0, At, B0); PG8_BAR; PG8_SCHED;
            PG8_STAGE(PG8_SB(1, 1), b3 + hstep, voffB);
            PG8_WAIT_V(6); PG8_BAR; PG8_MMA(1, 1, At, B1); PG8_BAR;
            }
        }
        if constexpr (ALIGN_EPI) { if (wr == 0) PG8_BAR; }
        E(acc, cur, wr, wc, fr, fq); S.done(cur);
        if (!has_next) break;
#pragma unroll
        for (int a = 0; a < 2; ++a)
#pragma unroll
            for (int b = 0; b < 2; ++b)
#pragma unroll
                for (int m = 0; m < 4; ++m)
#pragma unroll
                    for (int n = 0; n < 2; ++n) acc[a][b][m][n] = (f32x4){0.f, 0.f, 0.f, 0.f};
        cur = nxt; cA = nA; cB = nB; ++ui;
        if constexpr (ALIGN_EPI) { if (wr == 1) PG8_BAR; }
    }
    PG8_WAIT_V(0);
    if constexpr (!ALIGN_EPI) { if (wr == 0) PG8_BAR; }
    PG8_BAR;
#undef PG8_SA
#undef PG8_SB
#undef PG8_STAGE
#undef PG8_LDA
#undef PG8_LDB
#undef PG8_MMA
#undef PG8_WAIT_V
#undef PG8_WAIT_L
#undef PG8_BAR
#undef PG8_SCHED
}
template <class Epi>
__device__ __forceinline__ void gemm_run(LAS unsigned char* lds, const Gemm g, const StaticOrder& S, const Epi& E, const int tid) { gemm_phase<Epi, StaticOrder, GEMM_ALIGN, GEMM_SP2>(lds, g, S, E, tid); }
}

struct EpiP {
    static constexpr bool PERM = true;
    bf16_t* O;
    __device__ __forceinline__ void operator()(const f32x4 (&acc)[2][2][4][2], const pg8::Unit& u, int wr, int wc, int fr, int fq) const {
        const int row0 = u.pm * 256 + wr * 64 + fr, col0 = u.pn * 256 + wc * 32 + 8 * fq;
#pragma unroll
        for (int ai = 0; ai < 2; ++ai)
#pragma unroll
            for (int m = 0; m < 4; ++m) { bf16_t* rowp = O + (size_t)(row0 + ai * 128 + m * 16) * NP + col0;
#pragma unroll
                for (int bj = 0; bj < 2; ++bj) { const f32x4 v0 = acc[ai][bj][m][0], v1 = acc[ai][bj][m][1];
                    u32x4 w; w.x = cvt_pk_bf16(v0[0], v0[1]); w.y = cvt_pk_bf16(v0[2], v0[3]); w.z = cvt_pk_bf16(v1[0], v1[1]); w.w = cvt_pk_bf16(v1[2], v1[3]);
                    *(u32x4*)(rowp + bj * 128) = w; } }
    }
};
struct EpiLora {
    static constexpr bool PERM = true;
    unsigned short *X, *Ab; const float *w0, *a0;
    __device__ __forceinline__ void operator()(const f32x4 (&acc)[2][2][4][2], const pg8::Unit& u, int wr, int wc, int fr, int fq) const {
        const int row0 = u.pm * 256 + wr * 64 + fr; const int colt = u.pn * 256; const bool isA = colt >= 2048;
        unsigned short* base = isA ? Ab : X; const float* bias = isA ? a0 : w0; const float scale = isA ? 1.0f : 0.60653065971f;
        const int cc = (colt & 2047) + wc * 32 + 8 * fq;
        f32x4 bv[2][2];
#pragma unroll
        for (int bj = 0; bj < 2; ++bj) { bv[bj][0] = *(const f32x4*)(bias + cc + bj * 128); bv[bj][1] = *(const f32x4*)(bias + cc + bj * 128 + 4); }
#pragma unroll
        for (int ai = 0; ai < 2; ++ai)
#pragma unroll
            for (int m = 0; m < 4; ++m) { unsigned short* rowp = base + (size_t)(row0 + ai * 128 + m * 16) * DB + cc;
#pragma unroll
                for (int bj = 0; bj < 2; ++bj) { const f32x4 v0 = acc[ai][bj][m][0] + bv[bj][0], v1 = acc[ai][bj][m][1] + bv[bj][1];
                    u32x4 w; w.x = pack_h2(scale * sigmoidf_(v0[0]), scale * sigmoidf_(v0[1])); w.y = pack_h2(scale * sigmoidf_(v0[2]), scale * sigmoidf_(v0[3]));
                    w.z = pack_h2(scale * sigmoidf_(v1[0]), scale * sigmoidf_(v1[1])); w.w = pack_h2(scale * sigmoidf_(v1[2]), scale * sigmoidf_(v1[3]));
                    *(u32x4*)(rowp + bj * 128) = w; } }
    }
};
template <bool ACCUM> struct EpiY {
    static constexpr bool PERM = true;
    bf16_t* Mg; const bf16_t* P; int gcol;
    __device__ __forceinline__ void operator()(const f32x4 (&acc)[2][2][4][2], const pg8::Unit& u, int wr, int wc, int fr, int fq) const {
        const int row0 = u.pm * 256 + wr * 64 + fr, col0 = u.pn * 256 + wc * 32 + 8 * fq;
#pragma unroll
        for (int ai = 0; ai < 2; ++ai)
#pragma unroll
            for (int m = 0; m < 4; ++m) { const int row = row0 + ai * 128 + m * 16;
#pragma unroll
                for (int bj = 0; bj < 2; ++bj) { const int col = col0 + bj * 128;
                    const u32x4 gw = *(const u32x4*)(P + (size_t)row * NP + gcol + col);
                    float g[8], o[8]; unpack8(gw, g);
                    const f32x4 v0 = acc[ai][bj][m][0], v1 = acc[ai][bj][m][1];
#pragma unroll
                    for (int e = 0; e < 4; ++e) { o[e] = sigmoidf_(g[e]) * v0[e]; o[4 + e] = sigmoidf_(g[4 + e]) * v1[e]; }
                    bf16_t* dst = Mg + (size_t)row * D + col;
                    if (ACCUM) { const u32x4 ow = *(const u32x4*)dst; float od[8]; unpack8(ow, od);
#pragma unroll
                        for (int e = 0; e < 8; ++e) o[e] += od[e]; }
                    *(u32x4*)dst = pack8(o); } }
    }
};
struct EpiOut {
    static constexpr bool PERM = false;
    float* H;
    __device__ __forceinline__ void operator()(const f32x4 (&acc)[2][2][4][2], const pg8::Unit& u, int wr, int wc, int fr, int fq) const {
        const int row0 = u.pm * 256 + wr * 64 + fr, col0 = u.pn * 256 + wc * 32 + 4 * fq;
#pragma unroll
        for (int ai = 0; ai < 2; ++ai)
#pragma unroll
            for (int m = 0; m < 4; ++m) { float* rowp = H + (size_t)(row0 + ai * 128 + m * 16) * D + col0;
#pragma unroll
                for (int bj = 0; bj < 2; ++bj)
#pragma unroll
                    for (int n = 0; n < 2; ++n) { f32x4* ptr = (f32x4*)(rowp + bj * 128 + n * 16); *ptr = ALPHA * (*ptr) + acc[ai][bj][m][n]; } }
    }
};


template <int KS  >
__device__ __forceinline__ f32x4 meta_dot(const bf16_t* A  , const bf16_t* Bt  , int K, int ct, int k0, int fr, int fq) {
    f32x4 acc = (f32x4){0.f, 0.f, 0.f, 0.f};
    const bf16_t* ap = A + (size_t)fr * K + k0 + fq * 8; const bf16_t* bp = Bt + (size_t)(ct * 16 + fr) * K + k0 + fq * 8;
    bf16x8 a[KS / 32], b[KS / 32];
#pragma unroll
    for (int i = 0; i < KS / 32; ++i) { a[i] = *(const bf16x8*)(ap + i * 32); b[i] = *(const bf16x8*)(bp + i * 32); }
#pragma unroll
    for (int i = 0; i < KS / 32; ++i) acc = __builtin_amdgcn_mfma_f32_16x16x32_bf16(b[i], a[i], acc, 0, 0, 0);
    return acc;
}
__device__ __forceinline__ void meta_p4(const Params& P, int l, LAS unsigned char* lds, int wid, int lane) {
    if (blockIdx.x >= D / 16) return;
    const int ct = blockIdx.x, fr = lane & 15, fq = lane >> 4;
    const f32x4 ya = meta_dot<DA / 8>((const bf16_t*)(P.ws + WS_CO) + (size_t)NREAL * DA, (const bf16_t*)(P.ws + WS_WA) + (size_t)l * D * DA, DA, ct, wid * (DA / 8), fr, fq);
    const f32x4 yb = meta_dot<DB / 8>((const bf16_t*)(P.ws + WS_SB) + (size_t)NREAL * DB, (const bf16_t*)(P.ws + WS_WB) + (size_t)l * D * DB, DB, ct, wid * (DB / 8), fr, fq);
    LAS f32x4* red = (LAS f32x4*)lds;
    red[(wid * 2 + 0) * 64 + lane] = ya; red[(wid * 2 + 1) * 64 + lane] = yb;
    __syncthreads();
    if (wid == 0) {
        f32x4 sa = red[lane], sb2 = red[64 + lane];
#pragma unroll
        for (int w = 1; w < 8; ++w) { sa += red[(w * 2) * 64 + lane]; sb2 += red[(w * 2 + 1) * 64 + lane]; }
        const int row = NREAL + fr, c0 = ct * 16 + 4 * fq;
        const bf16_t* pr = (const bf16_t*)(P.ws + WS_P) + (size_t)row * NP;
        const u32x2 ga = *(const u32x2*)(pr + PC_GA + c0), gb = *(const u32x2*)(pr + PC_GB + c0);
        const float o0 = sigmoidf_(bf_lo(ga.x)) * sa[0] + sigmoidf_(bf_lo(gb.x)) * sb2[0], o1 = sigmoidf_(bf_hi(ga.x)) * sa[1] + sigmoidf_(bf_hi(gb.x)) * sb2[1];
        const float o2 = sigmoidf_(bf_lo(ga.y)) * sa[2] + sigmoidf_(bf_lo(gb.y)) * sb2[2], o3 = sigmoidf_(bf_hi(ga.y)) * sa[3] + sigmoidf_(bf_hi(gb.y)) * sb2[3];
        u32x2 w; w.x = cvt_pk_bf16(o0, o1); w.y = cvt_pk_bf16(o2, o3);
        *(u32x2*)((bf16_t*)(P.ws + WS_HB) + (size_t)row * D + c0) = w;
    }
}
__device__ __forceinline__ void meta_p5(const Params& P, int l, LAS unsigned char* lds, int wid, int lane) {
    if (blockIdx.x >= D / 16) return;
    const int ct = blockIdx.x, fr = lane & 15, fq = lane >> 4;
    const f32x4 acc = meta_dot<D / 8>((const bf16_t*)(P.ws + WS_HB) + (size_t)NREAL * D, (const bf16_t*)(P.ws + WS_WO) + (size_t)l * D * D, D, ct, wid * (D / 8), fr, fq);
    LAS f32x4* red = (LAS f32x4*)lds;
    red[wid * 64 + lane] = acc;
    __syncthreads();
    if (wid == 0) {
        f32x4 sa = red[lane];
#pragma unroll
        for (int w = 1; w < 8; ++w) sa += red[w * 64 + lane];
        f32x4* ptr = (f32x4*)((float*)(P.ws + WS_HF) + (size_t)(NREAL + fr) * D + ct * 16 + 4 * fq);
        *ptr = ALPHA * (*ptr) + sa;
    }
}

__device__ __forceinline__ void transpose_item(const float* W, int ldw, int src_n0, int k0, bf16_t* WT, int K, int dst_n0, LAS float* scr, int lane) {
    if (src_n0 >= 0) {
        f32x4 v[8]; const int n4 = (lane & 7) * 4;
#pragma unroll
        for (int i = 0; i < 8; ++i) v[i] = *(const f32x4*)(W + (size_t)(k0 + (lane >> 3) + 8 * i) * ldw + src_n0 + n4);
#pragma unroll
        for (int i = 0; i < 8; ++i) { LAS float* d = scr + ((lane >> 3) + 8 * i) * 33 + n4; d[0] = v[i].x; d[1] = v[i].y; d[2] = v[i].z; d[3] = v[i].w; }
    }
    asm volatile("s_waitcnt lgkmcnt(0)" ::: "memory");
    const int c = lane & 7;
#pragma unroll
    for (int j = 0; j < 4; ++j) { const int n = (lane >> 3) + 8 * j; const LAS float* s = scr + (8 * c) * 33 + n;
        u32x4 o = (u32x4){0u, 0u, 0u, 0u};
        if (src_n0 >= 0) { o.x = cvt_pk_bf16(s[0 * 33], s[1 * 33]); o.y = cvt_pk_bf16(s[2 * 33], s[3 * 33]); o.z = cvt_pk_bf16(s[4 * 33], s[5 * 33]); o.w = cvt_pk_bf16(s[6 * 33], s[7 * 33]); }
        *(u32x4*)(WT + (size_t)(dst_n0 + n) * K + k0 + 8 * c) = o; }
    asm volatile("s_waitcnt lgkmcnt(0)" ::: "memory");
}
__device__ __forceinline__ int win_src_col(int j) { return j < 12288 ? j : (j < 16384 ? j + 192 : (j < 16576 ? j - 4096 : -1)); }

__device__ __forceinline__ void convert_win(const Params& P, int l, LAS unsigned char* lds, int gw, int ngw, int wid, int lane) {
    LAS float* scr = (LAS float*)(lds + wid * 8448);
    const float* W = P.w_in + (size_t)l * D * NCOLS; bf16_t* WT = (bf16_t*)(P.ws + WS_WIN);
    constexpr int NBLK = NP / 32;
    for (int it = gw; it < (D / 64) * NBLK; it += ngw) { const int kb = it / NBLK, nb = it % NBLK;
        transpose_item(W, NCOLS, win_src_col(nb * 32), kb * 64, WT, D, nb * 32, scr, lane); }
}
__device__ __forceinline__ void convert_small(const Params& P, LAS unsigned char* lds, int gw, int ngw, int wid, int lane) {
    LAS float* scr = (LAS float*)(lds + wid * 8448);
    constexpr int IA = (DA / 64) * (D / 32), IB = (DB / 64) * (D / 32), IO = (D / 64) * (D / 32), IL = IA + IB + IO;
    for (int it = gw; it < DEPTH * IL; it += ngw) { const int l = it / IL; int r = it % IL;
        if (r < IA) { transpose_item(P.w_a + (size_t)l * DA * D, D, (r % (D / 32)) * 32, (r / (D / 32)) * 64, (bf16_t*)(P.ws + WS_WA) + (size_t)l * D * DA, DA, (r % (D / 32)) * 32, scr, lane); continue; } r -= IA;
        if (r < IB) { transpose_item(P.w_b + (size_t)l * DB * D, D, (r % (D / 32)) * 32, (r / (D / 32)) * 64, (bf16_t*)(P.ws + WS_WB) + (size_t)l * D * DB, DB, (r % (D / 32)) * 32, scr, lane); continue; } r -= IB;
        transpose_item(P.w_out + (size_t)l * D * D, D, (r % (D / 32)) * 32, (r / (D / 32)) * 64, (bf16_t*)(P.ws + WS_WO) + (size_t)l * D * D, D, (r % (D / 32)) * 32, scr, lane); }
    bf16_t* WL = (bf16_t*)(P.ws + WS_WL);
    const size_t tot = (size_t)DEPTH * 4096 * 32;
    for (size_t it = (size_t)gw * 64 + lane; it < tot; it += (size_t)ngw * 64) {
        const int n = (int)(it % 4096); const int kc = (int)((it / 4096) % 32) * 8; const int l = (int)(it / (4096 * 32));
        float f[8];
#pragma unroll
        for (int e = 0; e < 8; ++e) { const int k = kc + e; float v = 0.f;
            if (n < 2048) { if (k < LORA) v = P.w2[((size_t)l * LORA + k) * DB + n]; }
            else { if (k >= 128 && k < 128 + LORA) v = P.a2[((size_t)l * LORA + (k - 128)) * DB + (n - 2048)]; }
            f[e] = v; }
        *(u32x4*)(WL + ((size_t)l * 4096 + n) * 256 + kc) = pack8(f);
    }
}
__device__ __forceinline__ void ln_row(const float* src, const float* g, const float* b, float* dstf, bf16_t* dstb, int lane) {
    const f32x4* xr = (const f32x4*)src + lane;
    f32x4 v[8]; float s = 0.f;
#pragma unroll
    for (int j = 0; j < 8; ++j) { v[j] = xr[64 * j]; s += (v[j].x + v[j].y) + (v[j].z + v[j].w); }
    const float mean = wave_sum(s) * (1.f / D); float s2 = 0.f;
#pragma unroll
    for (int j = 0; j < 8; ++j) { v[j] = v[j] - mean; s2 += (v[j].x * v[j].x + v[j].y * v[j].y) + (v[j].z * v[j].z + v[j].w * v[j].w); }
    const float rstd = 1.f / sqrtf(wave_sum(s2) * (1.f / D) + LN_EPS);
#pragma unroll
    for (int j = 0; j < 8; ++j) { const f32x4 gg = ((const f32x4*)g)[lane + 64 * j], bb = ((const f32x4*)b)[lane + 64 * j];
        const f32x4 o = v[j] * rstd * gg + bb;
        if (dstf) ((f32x4*)dstf)[lane + 64 * j] = o;
        if (dstb) { u32x2 w; w.x = cvt_pk_bf16(o.x, o.y); w.y = cvt_pk_bf16(o.z, o.w); ((u32x2*)dstb)[lane + 64 * j] = w; } }
}
__device__ __forceinline__ void embed_phase(const Params& P, int gw, int ngw, int lane) {
    float* hf = (float*)(P.ws + WS_HF); bf16_t* hb = (bf16_t*)(P.ws + WS_HB);
    for (int r = gw; r < MPAD; r += ngw) {
        if (r < NROWS) { const float* src = r < NREAL ? P.x + (size_t)r * D : P.meta + (size_t)(r - NREAL) * D;
            ln_row(src, P.emb_g, P.emb_b, hf + (size_t)r * D, hb + (size_t)r * D, lane); }
        else {
#pragma unroll
            for (int j = 0; j < 8; ++j) { ((f32x4*)(hf + (size_t)r * D))[lane + 64 * j] = (f32x4){0.f, 0.f, 0.f, 0.f}; ((u32x2*)(hb + (size_t)r * D))[lane + 64 * j] = (u32x2){0u, 0u}; }
        }
    }
}
__device__ __forceinline__ void ln_phase(const Params& P, int l, int gw, int ngw, int lane) {
    float* hf = (float*)(P.ws + WS_HF); bf16_t* hb = (bf16_t*)(P.ws + WS_HB);
    const float* g = P.ln_g + (size_t)l * D; const float* b = P.ln_b + (size_t)l * D;
    if (l == DEPTH - 1) { for (int r = gw; r < NREAL; r += ngw) ln_row(hf + (size_t)r * D, g, b, P.out + (size_t)r * D, nullptr, lane); }
    else { for (int r = gw; r < NROWS; r += ngw) ln_row(hf + (size_t)r * D, g, b, hf + (size_t)r * D, hb + (size_t)r * D, lane); }
}

constexpr int RUN = 8, NRUN = NROWS / RUN;
__device__ __forceinline__ void p2_phase(const Params& P, int l, size_t gtid, size_t gthreads) {
    const bf16_t* p = (const bf16_t*)(P.ws + WS_P); bf16_t* co = (bf16_t*)(P.ws + WS_CO); bf16_t* al = (bf16_t*)(P.ws + WS_AL);
    const float* cw = P.conv_w + (size_t)l * 3 * DA; const float* mu = P.mu + (size_t)l * 8384;
    const size_t tot = (size_t)NRUN * 160;
    for (size_t it = gtid; it < tot; it += gthreads) {
        const int run = (int)(it / 160), ch = (int)(it % 160); const int row0 = run * RUN;
        const int r1 = prev_row(row0), r2 = r1 >= 0 ? prev_row(r1) : -1;
        if (ch < 128) {
            const int c0 = ch * 8;
            float w0[8], w1[8], w2[8], u1[8], u2[8], xa[8], xb[8];
#pragma unroll
            for (int e = 0; e < 8; ++e) { w0[e] = cw[c0 + e]; w1[e] = cw[DA + c0 + e]; w2[e] = cw[2 * DA + c0 + e]; u1[e] = 0.f; u2[e] = 0.f; }
            if (r1 >= 0) { const bf16_t* q = p + (size_t)r1 * NP; unpack8(*(const u32x4*)(q + PC_XIN + c0), xa); unpack8(*(const u32x4*)(q + PC_CG + c0), xb);
#pragma unroll
                for (int e = 0; e < 8; ++e) u1[e] = xa[e] * xb[e]; }
            if (r2 >= 0) { const bf16_t* q = p + (size_t)r2 * NP; unpack8(*(const u32x4*)(q + PC_XIN + c0), xa); unpack8(*(const u32x4*)(q + PC_CG + c0), xb);
#pragma unroll
                for (int e = 0; e < 8; ++e) u2[e] = xa[e] * xb[e]; }
            u32x4 Lx[RUN], Lc[RUN], Lb[RUN], Lz[RUN];
#pragma unroll
            for (int rr = 0; rr < RUN; ++rr) { const bf16_t* pr = p + (size_t)(row0 + rr) * NP + c0; Lx[rr] = *(const u32x4*)(pr + PC_XIN); Lc[rr] = *(const u32x4*)(pr + PC_CG); Lb[rr] = *(const u32x4*)(pr + PC_BG); Lz[rr] = *(const u32x4*)(pr + PC_ZA); }
#pragma unroll
            for (int rr = 0; rr < RUN; ++rr) {
                float bg[8], z[8], o[8], u0[8]; unpack8(Lx[rr], xa); unpack8(Lc[rr], xb); unpack8(Lb[rr], bg); unpack8(Lz[rr], z);
#pragma unroll
                for (int e = 0; e < 8; ++e) { u0[e] = xa[e] * xb[e]; const float cv = w0[e] * u2[e] + w1[e] * u1[e] + w2[e] * u0[e]; o[e] = bg[e] * cv * siluf_(z[e]); u2[e] = u1[e]; u1[e] = u0[e]; }
                *(u32x4*)(co + (size_t)(row0 + rr) * DA + c0) = pack8(o);
            }
        } else {
            const int kc = (ch - 128) * 8;
            const bool isw = kc < LORA, isa = (kc >= 128 && kc < 128 + LORA);
            if (isw || isa) {
                const int pc = isw ? PC_WLO + kc : PC_ALO + (kc - 128); const int mi = isw ? 8192 + kc : 8288 + (kc - 128);
                float m[8], q[8], c[8], o[8];
#pragma unroll
                for (int e = 0; e < 8; ++e) { m[e] = mu[mi + e]; q[e] = 0.f; }
                if (r1 >= 0) unpack8(*(const u32x4*)(p + (size_t)r1 * NP + pc), q);
                u32x4 Lc[RUN];
#pragma unroll
                for (int rr = 0; rr < RUN; ++rr) Lc[rr] = *(const u32x4*)(p + (size_t)(row0 + rr) * NP + pc);
#pragma unroll
                for (int rr = 0; rr < RUN; ++rr) { unpack8(Lc[rr], c);
#pragma unroll
                    for (int e = 0; e < 8; ++e) { const float v = c[e] + m[e] * (q[e] - c[e]); o[e] = isw ? tanhf(v) : v; q[e] = c[e]; }
                    *(u32x4*)(al + (size_t)(row0 + rr) * 256 + kc) = pack8(o); }
            } else {
#pragma unroll
                for (int rr = 0; rr < RUN; ++rr) *(u32x4*)(al + (size_t)(row0 + rr) * 256 + kc) = (u32x4){0u, 0u, 0u, 0u};
            }
        }
    }
}

constexpr int TC = 32, NCH = 1 + SEQ / TC;
constexpr int REC = 1280;
constexpr int SC_OPND = 0, SC_V = TC * REC, SC_Y = SC_V + TC * 16 * 8, SC_BUF = SC_Y + TC * 16 * 4;
#define SCAN_BARRIER() do { asm volatile("s_waitcnt lgkmcnt(0)" ::: "memory"); __builtin_amdgcn_s_barrier(); asm volatile("" ::: "memory"); } while (0)
__device__ __forceinline__ void scan_phase(const Params& P, int l, LAS unsigned char* lds, const int tid) {
    const int wid = __builtin_amdgcn_readfirstlane(tid >> 6), lane = tid & 63;
    const bf16_t* p = (const bf16_t*)(P.ws + WS_P); const unsigned short* xb = (const unsigned short*)(P.ws + WS_HB); const unsigned short* ab = (const unsigned short*)(P.ws + WS_AB);
    bf16_t* sb = (bf16_t*)(P.ws + WS_SB); float* bon = (float*)(P.ws + WS_BON);
    for (int item = blockIdx.x; item < 256; item += gridDim.x) {
        const int xcd_ = item & 7, y_ = item >> 3, hh_ = xcd_ * 8 + (y_ >> 2);
        const int b = hh_ >> 5, h = hh_ & 31, q = y_ & 3;
        const int j = tid & 255, tt = j >> 3, cgp = j & 7, c0 = h * 64 + cgp * 8;
        const bool vown = (cgp >> 1) == q;
        u32x4 LAr0, LAr1, LAk0, LAk1, LAv0, LAv1, LAx, LAa, LBr0, LBr1, LBk0, LBk1, LBv0, LBv1, LBx, LBa;
        LAr0 = LAr1 = LAk0 = LAk1 = LAv0 = LAv1 = LAx = LAa = LBr0 = LBr1 = LBk0 = LBk1 = LBv0 = LBv1 = LBx = LBa = (u32x4){0u, 0u, 0u, 0u};
        const int rl = lane >> 4, kq = lane & 15, rowl = (wid & 3) * 4 + rl;
        f32x2 s01 = (f32x2){0.f, 0.f}, s23 = (f32x2){0.f, 0.f}; float yacc = 0.f;
#define CHUNK_ROW(c, t) ((c) == 0 ? NREAL + (t) : b * SEQ + ((c) - 1) * TC + (t))
#define ISSUE_LOADS(L, c) do { const bool valid_ = ((c) > 0) || (tt < NMETA); if (valid_) { const int row_ = CHUNK_ROW(c, tt); const int pr_ = prev_row(row_); \
            const bf16_t* a_ = p + (size_t)row_ * NP + c0; L##r0 = *(const u32x4*)(a_ + PC_R); L##k0 = *(const u32x4*)(a_ + PC_K); if (vown) L##v0 = *(const u32x4*)(a_ + PC_V); \
            L##x = *(const u32x4*)(xb + (size_t)row_ * DB + c0); L##a = *(const u32x4*)(ab + (size_t)row_ * DB + c0); \
            if (pr_ >= 0) { const bf16_t* a1_ = p + (size_t)pr_ * NP + c0; L##r1 = *(const u32x4*)(a1_ + PC_R); L##k1 = *(const u32x4*)(a1_ + PC_K); if (vown) L##v1 = *(const u32x4*)(a1_ + PC_V); } \
            else { L##r1 = L##k1 = L##v1 = (u32x4){0u, 0u, 0u, 0u}; } } } while (0)
        if (wid >= 4) {
            if (j < 96) {
                const float* mu = P.mu + (size_t)l * 8384; const int arr = j >> 4, c4 = h * 64 + (j & 15) * 4;
                const float* src = arr == 0 ? mu + c4 : arr == 1 ? mu + 2048 + c4 : arr == 2 ? mu + 4096 + c4 : arr == 3 ? P.kks + (size_t)l * DB + c4 : arr == 4 ? P.kas + (size_t)l * DB + c4 : P.rk + (size_t)l * DB + c4;
                ((LAS f32x4*)(lds + 2 * SC_BUF))[j] = *(const f32x4*)src;
            }
            ISSUE_LOADS(LA, 0); ISSUE_LOADS(LB, 1);
        } else {
            __builtin_amdgcn_s_setprio(2);
        }
        __syncthreads();
        float mur[8], muk[8], kks[8], kas[8], rks[8];
        { LAS const f32x4* cst_ = (LAS const f32x4*)(lds + 2 * SC_BUF) + cgp * 2;
#pragma unroll
          for (int e = 0; e < 4; ++e) { mur[e] = cst_[0][e]; mur[4 + e] = cst_[1][e]; muk[e] = cst_[16][e]; muk[4 + e] = cst_[17][e]; kks[e] = cst_[48][e]; kks[4 + e] = cst_[49][e];
              kas[e] = cst_[64][e]; kas[4 + e] = cst_[65][e]; rks[e] = cst_[80][e]; rks[4 + e] = cst_[81][e]; } }
#define SCAN_ITER(L, i) do { \
            if (wid >= 4) { \
                if ((i) >= 2 && (i) - 2 < NCH) {     \
                    const int c = (i) - 2; const bool valid = (c > 0) ? true : (tt < NMETA && b == 0); \
                    if (valid) { const LAS f32x2* yb = (const LAS f32x2*)(lds + ((i) & 1) * SC_BUF + SC_Y + tt * 64) + cgp; const f32x2 y = *yb; \
                        const f32x4 vc_ = *((const LAS f32x4*)(lds + ((i) & 1) * SC_BUF + SC_V + tt * 128) + cgp); \
                        *(unsigned*)(sb + (size_t)CHUNK_ROW(c, tt) * DB + h * 64 + q * 16 + 2 * cgp) = cvt_pk_bf16(y.x + vc_.y, y.y + vc_.w); } \
                } \
                if ((i) < NCH) { \
                    LAS unsigned char* buf = lds + ((i) & 1) * SC_BUF; \
                    const bool valid = ((i) > 0) || (tt < NMETA); \
                    float r0[8], r1[8], k0[8], k1[8], xx[8], aa[8]; \
                    unpack8(L##r0, r0); unpack8(L##r1, r1); unpack8(L##k0, k0); unpack8(L##k1, k1); unpack8h(L##x, xx); unpack8h(L##a, aa); \
                    float rr[8], kp[8], kkv[8], dec[8]; float ss = 0.f; \
                    _Pragma("unroll") for (int e = 0; e < 8; ++e) { rr[e] = r0[e] + mur[e] * (r1[e] - r0[e]); kp[e] = k0[e] + muk[e] * (k1[e] - k0[e]); dec[e] = __expf(-xx[e]); \
                        kkv[e] = kp[e] * kks[e]; ss += kkv[e] * kkv[e]; } \
                    ss = allred8(ss); \
                    const float inv = __builtin_amdgcn_rsqf(fmaxf(ss, 1e-24f)); \
                    float kk[8], kka[8], kt[8], wr[8]; float bs = 0.f, c1 = 0.f, c2 = 0.f; \
                    _Pragma("unroll") for (int e = 0; e < 8; ++e) { kk[e] = kkv[e] * inv; kka[e] = kk[e] * aa[e]; kt[e] = kp[e] * (1.0f + (aa[e] - 1.0f) * kas[e]); bs += rr[e] * kt[e] * rks[e]; \
                        wr[e] = dec[e] * rr[e]; c1 += kka[e] * rr[e]; c2 += kt[e] * rr[e]; } \
                    bs = allred8(bs); c1 = allred8(c1); c2 = allred8(c2); \
                    if (valid) { \
                        LAS f32x4* o = (LAS f32x4*)(buf + SC_OPND + tt * REC) + cgp * 2; \
                        float rp[8]; _Pragma("unroll") for (int e = 0; e < 8; ++e) rp[e] = wr[e] - c1 * kk[e]; \
                        o[0] = (f32x4){kk[0], rp[0], kk[1], rp[1]}; o[1] = (f32x4){kk[4], rp[4], kk[5], rp[5]}; \
                        o[16] = (f32x4){kk[2], rp[2], kk[3], rp[3]}; o[17] = (f32x4){kk[6], rp[6], kk[7], rp[7]}; \
                        o[32] = (f32x4){dec[0], dec[1], dec[2], dec[3]}; o[33] = (f32x4){dec[4], dec[5], dec[6], dec[7]}; \
                        o[48] = (f32x4){kka[0], kka[1], kka[2], kka[3]}; o[49] = (f32x4){kka[4], kka[5], kka[6], kka[7]}; \
                        o[64] = (f32x4){kt[0], kt[1], kt[2], kt[3]}; o[65] = (f32x4){kt[4], kt[5], kt[6], kt[7]}; \
                        if (vown) { float v0[8], v1[8], muv[8]; unpack8(L##v0, v0); unpack8(L##v1, v1); \
                            { LAS const f32x4* cst_ = (LAS const f32x4*)(lds + 2 * SC_BUF) + cgp * 2; _Pragma("unroll") for (int e = 0; e < 4; ++e) { muv[e] = cst_[32][e]; muv[4 + e] = cst_[33][e]; } } \
                            LAS f32x4* vo = (LAS f32x4*)(buf + SC_V + tt * 128) + (cgp & 1) * 4; \
                            float vv[8]; \
                            _Pragma("unroll") for (int e = 0; e < 8; ++e) vv[e] = v0[e] + muv[e] * (v1[e] - v0[e]); \
                            vo[0] = (f32x4){vv[0], vv[0] * c2, vv[1], vv[1] * c2}; vo[1] = (f32x4){vv[2], vv[2] * c2, vv[3], vv[3] * c2}; \
                            vo[2] = (f32x4){vv[4], vv[4] * c2, vv[5], vv[5] * c2}; vo[3] = (f32x4){vv[6], vv[6] * c2, vv[7], vv[7] * c2}; } \
                        if (q == 0 && cgp == 0 && ((i) > 0 || b == 0)) bon[(size_t)CHUNK_ROW(i, tt) * 32 + h] = bs; \
                    } \
                } \
                if ((i) + 2 < NCH) ISSUE_LOADS(L, (i) + 2); \
            } else { \
                if ((i) >= 1 && (i) <= NCH) { \
                    const int c = (i) - 1; const int ntok = c == 0 ? NMETA : TC; \
                    LAS const unsigned char* buf = lds + (c & 1) * SC_BUF; \
                    LAS float* ybuf = (LAS float*)(lds + (c & 1) * SC_BUF + SC_Y) + (15 - kq) * 16 + rowl; \
                    f32x4 Akra, Akrb, Aw, Aka, Ak, Bkra, Bkrb, Bw, Bka, Bk; f32x2 Av, Bv; \
                    LAS const unsigned char* ob = buf + SC_OPND + kq * 16; LAS const unsigned char* vb = buf + SC_V + rowl * 8; \
                    LOADOPS(A, 0); \
                    _Pragma("unroll 1") for (int g = 0; g < ntok; g += 16) { \
                        asm volatile("" : "+v"(ob), "+v"(vb));     \
                        _Pragma("unroll") for (int u = 0; u < 8; ++u) { LOADOPS(B, 2 * u + 1); STEP(A); LOADOPS(A, 2 * u + 2); STEP(B); } \
                        ob += 16 * REC; vb += 16 * 128; \
                        ybuf[g * 16] = yacc; } \
                } \
            } \
            SCAN_BARRIER(); } while (0)
#define LOADOPS(S, t) do { S##kra = *(LAS const f32x4*)(ob + (t) * REC); S##krb = *(LAS const f32x4*)(ob + (t) * REC + 256); S##w = *(LAS const f32x4*)(ob + (t) * REC + 512); \
                        S##ka = *(LAS const f32x4*)(ob + (t) * REC + 768); S##k = *(LAS const f32x4*)(ob + (t) * REC + 1024); S##v = *(LAS const f32x2*)(vb + (t) * 128); } while (0)
#define LO2(v) __builtin_shufflevector(v, v, 0, 1)
#define HI2(v) __builtin_shufflevector(v, v, 2, 3)
#define STEP(S) do { \
                        f32x2 P_ = (f32x2){s01.x, s01.x} * LO2(S##kra); \
                        P_ = (f32x2){s01.y, s01.y} * HI2(S##kra) + P_; \
                        P_ = (f32x2){s23.x, s23.x} * LO2(S##krb) + P_; \
                        P_ = (f32x2){s23.y, s23.y} * HI2(S##krb) + P_; \
                        float sa_ = P_.x, yp_ = P_.y; \
                        f32x2 m01_ = s01 * LO2(S##w), m23_ = s23 * HI2(S##w); \
                        sa_ += dpp_mov<0xB1>(sa_); yp_ += dpp_mov<0xB1>(yp_); \
                        m01_ = (f32x2){S##v.x, S##v.x} * LO2(S##k) + m01_; \
                        sa_ += dpp_mov<0x4E>(sa_); yp_ += dpp_mov<0x4E>(yp_); \
                        m23_ = (f32x2){S##v.x, S##v.x} * HI2(S##k) + m23_; \
                        sa_ += dpp_mov<0x141>(sa_); yp_ += dpp_mov<0x141>(yp_); sa_ += dpp_mov<0x128>(sa_); yp_ += dpp_mov<0x128>(yp_); \
                        const f32x2 sa2_ = (f32x2){sa_, sa_}; \
                        s01 = m01_ - sa2_ * LO2(S##ka); s23 = m23_ - sa2_ * HI2(S##ka); \
                        yacc = __builtin_bit_cast(float, __builtin_amdgcn_update_dpp(__builtin_bit_cast(int, yp_), __builtin_bit_cast(int, yacc), 0x111, 0xf, 0xf, false)); } while (0)
#pragma unroll 1
        for (int i = 0; i < NCH + 2; i += 2) { SCAN_ITER(LA, i); SCAN_ITER(LB, i + 1); }
        if (wid < 4) __builtin_amdgcn_s_setprio(0);
        __syncthreads();
    }
}

__device__ __forceinline__ void p3b_phase(const Params& P, int l, size_t gtid, size_t gthreads) {
    const bf16_t* p = (const bf16_t*)(P.ws + WS_P); bf16_t* sb = (bf16_t*)(P.ws + WS_SB); const float* bon = (const float*)(P.ws + WS_BON);
    const float* mu = P.mu + (size_t)l * 8384; const float* gg = P.gn_g + (size_t)l * DB; const float* gb = P.gn_b + (size_t)l * DB;
    const size_t tot = (size_t)NRUN * 256;
    for (size_t it = gtid; it < tot; it += gthreads) {
        const int run = (int)(it >> 8), h = (int)((it >> 3) & 31), c0 = h * 64 + (int)(it & 7) * 8; const int row0 = run * RUN; const int r1 = prev_row(row0);
        float mv[8], mz[8], g8[8], b8[8], v1[8], z1[8];
#pragma unroll
        for (int e = 0; e < 8; ++e) { mv[e] = mu[4096 + c0 + e]; mz[e] = mu[6144 + c0 + e]; g8[e] = gg[c0 + e]; b8[e] = gb[c0 + e]; v1[e] = 0.f; z1[e] = 0.f; }
        if (r1 >= 0) { unpack8(*(const u32x4*)(p + (size_t)r1 * NP + PC_V + c0), v1); unpack8(*(const u32x4*)(p + (size_t)r1 * NP + PC_Z + c0), z1); }
        u32x4 Ly[RUN], Lv[RUN], Lz[RUN]; float Lb[RUN];
#pragma unroll
        for (int rr = 0; rr < RUN; ++rr) { const size_t row = (size_t)(row0 + rr); Ly[rr] = *(const u32x4*)(sb + row * DB + c0); Lv[rr] = *(const u32x4*)(p + row * NP + PC_V + c0); Lz[rr] = *(const u32x4*)(p + row * NP + PC_Z + c0); Lb[rr] = bon[row * 32 + h]; }
#pragma unroll
        for (int rr = 0; rr < RUN; ++rr) {
            float y[8], v0[8], z0[8], o[8]; unpack8(Ly[rr], y); unpack8(Lv[rr], v0); unpack8(Lz[rr], z0);
            float s1 = 0.f;
#pragma unroll
            for (int e = 0; e < 8; ++e) s1 += y[e];
            const float mean = allred8(s1) * (1.f / 64.f); float s2 = 0.f;
#pragma unroll
            for (int e = 0; e < 8; ++e) { y[e] -= mean; s2 += y[e] * y[e]; }
            const float rstd = __builtin_amdgcn_rsqf(allred8(s2) * (1.f / 64.f) + GN_EPS); const float bs = Lb[rr];
#pragma unroll
            for (int e = 0; e < 8; ++e) { const float vp = v0[e] + mv[e] * (v1[e] - v0[e]); const float zp = z0[e] + mz[e] * (z1[e] - z0[e]);
                o[e] = (y[e] * rstd * g8[e] + b8[e] + bs * vp) * siluf_(zp); v1[e] = v0[e]; z1[e] = z0[e]; }
            *(u32x4*)(sb + (size_t)(row0 + rr) * DB + c0) = pack8(o);
        }
    }
}

constexpr size_t WS_DBG = WS_END;
__device__ __forceinline__ void dbg_fail(const Params& P, unsigned bit) { atomicOr((unsigned*)(P.ws + WS_DBG), bit); }
__device__ __forceinline__ float bf2f(bf16_t v) { return __uint_as_float((unsigned)v << 16); }
__device__ __forceinline__ float h2f(unsigned short v) { return (float)__builtin_bit_cast(_Float16, v); }
__device__ __forceinline__ void chk_gemm1(const Params& P, int gw, int ngw, int lane) {
    const bf16_t* hb = (const bf16_t*)(P.ws + WS_HB); const bf16_t* wt = (const bf16_t*)(P.ws + WS_WIN); const bf16_t* p = (const bf16_t*)(P.ws + WS_P);
    for (int i = gw; i < 4096; i += ngw) { const int row = (int)(((long)i * 977) % NROWS), col = (int)(((long)i * 613) % NP);
        float s = 0.f; for (int k = lane; k < D; k += 64) s += bf2f(hb[(size_t)row * D + k]) * bf2f(wt[(size_t)col * D + k]);
        s = wave_sum(s); const float got = bf2f(p[(size_t)row * NP + col]);
        if (lane == 0 && !(fabsf(got - s) <= 0.03f + 0.02f * fabsf(s))) dbg_fail(P, 1u); }
}
__device__ __forceinline__ void chk_lora(const Params& P, int l, int gw, int ngw, int lane) {
    const bf16_t* al = (const bf16_t*)(P.ws + WS_AL); const bf16_t* wl = (const bf16_t*)(P.ws + WS_WL) + (size_t)l * 4096 * 256;
    const unsigned short* xb = (const unsigned short*)(P.ws + WS_HB); const unsigned short* ab = (const unsigned short*)(P.ws + WS_AB);
    for (int i = gw; i < 4096; i += ngw) { const int row = (int)(((long)i * 977) % NROWS), c = (int)(((long)i * 613) % DB);
        float s1 = 0.f, s2 = 0.f; for (int k = lane; k < 256; k += 64) { const float av = bf2f(al[(size_t)row * 256 + k]); s1 += av * bf2f(wl[(size_t)c * 256 + k]); s2 += av * bf2f(wl[(size_t)(2048 + c) * 256 + k]); }
        s1 = wave_sum(s1); s2 = wave_sum(s2);
        const float xr = 0.60653065971f / (1.f + expf(-(P.w0[(size_t)l * DB + c] + s1))), ar = 1.f / (1.f + expf(-(P.a0[(size_t)l * DB + c] + s2)));
        const float xg = h2f(xb[(size_t)row * DB + c]), ag = h2f(ab[(size_t)row * DB + c]);
        if (lane == 0 && !(fabsf(xg - xr) <= 1e-4f + 0.01f * fabsf(xr))) dbg_fail(P, 2u);
        if (lane == 0 && !(fabsf(ag - ar) <= 1e-3f + 0.01f * fabsf(ar))) dbg_fail(P, 4u); }
}
__device__ __forceinline__ void chk_scan(const Params& P, int l, LAS unsigned char* lds, int gw, int wid, int lane) {
    if (gw >= 8) return;
    const int b = gw & 1, h = (gw * 5 + 3) & 31;
    LAS float* S = (LAS float*)(lds + wid * 16384); LAS float* op = S + 64 * 49;
    const bf16_t* p = (const bf16_t*)(P.ws + WS_P); const unsigned short* xb = (const unsigned short*)(P.ws + WS_HB); const unsigned short* ab = (const unsigned short*)(P.ws + WS_AB);
    const bf16_t* sb = (const bf16_t*)(P.ws + WS_SB); const float* bon = (const float*)(P.ws + WS_BON);
    const float* mu = P.mu + (size_t)l * 8384; const int c = h * 64 + lane;
    (void)S; (void)op;
    LAS float* st = S + lane * 64;
    for (int k = 0; k < 64; ++k) st[(k + lane) & 63] = 0.f;
    const float mur = mu[c], muk = mu[2048 + c], muv = mu[4096 + c], kks = P.kks[(size_t)l * DB + c], kas = P.kas[(size_t)l * DB + c], rks = P.rk[(size_t)l * DB + c];
    for (int tau = 0; tau < 16 + 40; ++tau) {
        const int row = tau < 16 ? NREAL + tau : b * SEQ + (tau - 16); const int pr = prev_row(row);
        const float r0 = bf2f(p[(size_t)row * NP + PC_R + c]), k0 = bf2f(p[(size_t)row * NP + PC_K + c]), v0 = bf2f(p[(size_t)row * NP + PC_V + c]);
        const float r1 = pr >= 0 ? bf2f(p[(size_t)pr * NP + PC_R + c]) : 0.f, k1 = pr >= 0 ? bf2f(p[(size_t)pr * NP + PC_K + c]) : 0.f, v1 = pr >= 0 ? bf2f(p[(size_t)pr * NP + PC_V + c]) : 0.f;
        const float rr = r0 + mur * (r1 - r0), kp = k0 + muk * (k1 - k0), vp = v0 + muv * (v1 - v0);
        const float x = h2f(xb[(size_t)row * DB + c]), a = h2f(ab[(size_t)row * DB + c]);
        const float w = expf(-x); const float kkv = kp * kks; const float nrm = sqrtf(wave_sum(kkv * kkv)); const float kk = kkv / fmaxf(nrm, 1e-12f);
        const float kka = kk * a, kt = kp * (1.f + (a - 1.f) * kas);
        const float bs = wave_sum(rr * kt * rks);
        float sa = 0.f;
#pragma unroll 1
        for (int k = 0; k < 64; ++k) sa += st[(k + lane) & 63] * __shfl(kk, k);
        float y = 0.f;
#pragma unroll 1
        for (int k = 0; k < 64; ++k) { const float nv = st[(k + lane) & 63] * __shfl(w, k) - sa * __shfl(kka, k) + vp * __shfl(kt, k); st[(k + lane) & 63] = nv; y += nv * __shfl(rr, k); }
        if (tau >= 16 || b == 0) {
            const float yg = bf2f(sb[(size_t)row * DB + c]);
            if (!(fabsf(yg - y) <= 0.02f + 0.02f * fabsf(y))) dbg_fail(P, 8u);
            if (lane == 0 && !(fabsf(bon[(size_t)row * 32 + h] - bs) <= 1e-3f + 1e-3f * fabsf(bs))) dbg_fail(P, 16u);
        }
    }
}
__device__ __forceinline__ void chk_merged(const Params& P, int l, int gw, int ngw, int lane) {
    const bf16_t* co = (const bf16_t*)(P.ws + WS_CO); const bf16_t* sb = (const bf16_t*)(P.ws + WS_SB); const bf16_t* p = (const bf16_t*)(P.ws + WS_P); const bf16_t* mg = (const bf16_t*)(P.ws + WS_HB);
    const bf16_t* wa = (const bf16_t*)(P.ws + WS_WA) + (size_t)l * D * DA; const bf16_t* wb = (const bf16_t*)(P.ws + WS_WB) + (size_t)l * D * DB;
    for (int i = gw; i < 4096; i += ngw) { const int row = (int)(((long)i * 977) % NROWS), c = (int)(((long)i * 613) % D);
        float s1 = 0.f, s2 = 0.f; for (int k = lane; k < DA; k += 64) s1 += bf2f(co[(size_t)row * DA + k]) * bf2f(wa[(size_t)c * DA + k]);
        for (int k = lane; k < DB; k += 64) s2 += bf2f(sb[(size_t)row * DB + k]) * bf2f(wb[(size_t)c * DB + k]);
        s1 = wave_sum(s1); s2 = wave_sum(s2);
        const float ga = 1.f / (1.f + expf(-bf2f(p[(size_t)row * NP + PC_GA + c]))), gb = 1.f / (1.f + expf(-bf2f(p[(size_t)row * NP + PC_GB + c])));
        const float m = ga * s1 + gb * s2, got = bf2f(mg[(size_t)row * D + c]);
        if (lane == 0 && !(fabsf(got - m) <= 0.01f + 0.03f * fabsf(m))) dbg_fail(P, 32u); }
}
#define LAUNDER(v) asm volatile("" : "+v"(v))
#if defined(__HIP_DEVICE_COMPILE__)
#define GETPARAMS const Params P = *Pp
#else
#define GETPARAMS const Params P = Pformal
#endif
__global__ void __launch_bounds__(512, 2) fwd_megakernel(Params Pformal) {
    extern __shared__ __attribute__((aligned(16))) unsigned char shm[];
    LAS unsigned char* lds = (LAS unsigned char*)shm;
    cg::grid_group grid = cg::this_grid();
    const int G = gridDim.x;
#define TIDS() const __attribute__((address_space(4))) Params* Pp = (const __attribute__((address_space(4))) Params*)__builtin_amdgcn_kernarg_segment_ptr(); asm volatile("" : "+s"(Pp)); GETPARAMS; \
    bf16_t* hb = (bf16_t*)(P.ws + WS_HB); bf16_t* pbuf = (bf16_t*)(P.ws + WS_P); (void)hb; (void)pbuf; \
    int tid = threadIdx.x; LAUNDER(tid); const int wid = __builtin_amdgcn_readfirstlane(tid >> 6), lane = tid & 63; const int gw = blockIdx.x * 8 + wid, ngw = G * 8; (void)lane; (void)gw; (void)ngw
    { TIDS();
#ifdef DBG_CHECKS
      if (blockIdx.x == 0 && tid == 0) *(unsigned*)(P.ws + WS_DBG) = 0u;
#endif
      convert_small(P, lds, gw, ngw, wid, lane); }
    { TIDS(); convert_win(P, 0, lds, gw, ngw, wid, lane); }
    { TIDS(); embed_phase(P, gw, ngw, lane); }
    grid.sync();
    for (int l = 0; l < DEPTH; ++l) {
        {
            TIDS();
            pg8::Gemm g{hb, (const bf16_t*)(P.ws + WS_WIN), MPAD, NP, D}; pg8::StaticOrder S; S.init(MPAD, NP, G, blockIdx.x);
            EpiP E{pbuf}; pg8::gemm_run(lds, g, S, E, tid);
        }
        grid.sync();
#ifdef DBG_CHECKS
        if (l == 0) { TIDS(); chk_gemm1(P, gw, ngw, lane); }
#endif
        { TIDS(); p2_phase(P, l, (size_t)blockIdx.x * 512 + tid, (size_t)G * 512); }
        grid.sync();
        {
            TIDS();
            pg8::Gemm g{(const bf16_t*)(P.ws + WS_AL), (const bf16_t*)(P.ws + WS_WL) + (size_t)l * 4096 * 256, MPAD, 4096, 256}; pg8::StaticOrder S; S.init(MPAD, 4096, G, blockIdx.x);
            EpiLora E{(unsigned short*)(P.ws + WS_HB), (unsigned short*)(P.ws + WS_AB), P.w0 + (size_t)l * DB, P.a0 + (size_t)l * DB}; pg8::gemm_run(lds, g, S, E, tid);
        }
        grid.sync();
#ifdef DBG_CHECKS
        if (l == 0) { TIDS(); chk_lora(P, l, gw, ngw, lane); }
#endif
        { TIDS(); scan_phase(P, l, lds, tid); }
        grid.sync();
#ifdef DBG_CHECKS
        if (l == 0) { TIDS(); chk_scan(P, l, lds, gw, wid, lane); grid.sync(); }
#endif
        { TIDS(); p3b_phase(P, l, (size_t)blockIdx.x * 512 + tid, (size_t)G * 512); }
        if (l + 1 < DEPTH) { TIDS(); convert_win(P, l + 1, lds, gw, ngw, wid, lane); }
        grid.sync();
        {
            TIDS();
            pg8::StaticOrder S; S.init(NREAL, D, G, blockIdx.x);
            pg8::Gemm ga{(const bf16_t*)(P.ws + WS_CO), (const bf16_t*)(P.ws + WS_WA) + (size_t)l * D * DA, NREAL, D, DA};
            EpiY<false> Ea{hb, pbuf, PC_GA}; pg8::gemm_run(lds, ga, S, Ea, tid);
        }
        {
            TIDS();
            pg8::StaticOrder S; S.init(NREAL, D, G, blockIdx.x);
            pg8::Gemm gb{(const bf16_t*)(P.ws + WS_SB), (const bf16_t*)(P.ws + WS_WB) + (size_t)l * D * DB, NREAL, D, DB};
            EpiY<true> Eb{hb, pbuf, PC_GB}; pg8::gemm_run(lds, gb, S, Eb, tid);
        }
        { TIDS(); meta_p4(P, l, lds, wid, lane); }
        grid.sync();
#ifdef DBG_CHECKS
        if (l == 0) { TIDS(); chk_merged(P, l, gw, ngw, lane); }
#endif
        {
            TIDS();
            pg8::StaticOrder S; S.init(NREAL, D, G, blockIdx.x);
            pg8::Gemm g{hb, (const bf16_t*)(P.ws + WS_WO) + (size_t)l * D * D, NREAL, D, D};
            EpiOut E{(float*)(P.ws + WS_HF)}; pg8::gemm_run(lds, g, S, E, tid);
        }
        { TIDS(); meta_p5(P, l, lds, wid, lane); }
        grid.sync();
        { TIDS(); ln_phase(P, l, gw, ngw, lane); }
        if (l + 1 < DEPTH) grid.sync();
    }
#ifdef DBG_CHECKS
    grid.sync();
    { TIDS(); if (blockIdx.x == 0 && tid == 0) { const unsigned f = *(volatile unsigned*)(P.ws + WS_DBG); if (f) P.out[0] = 100.f * (float)(10 + f); } }
#endif
}

constexpr int LDS_BYTES = 131072;
extern "C" void kernel_launch(void* const* d_in, const int* in_sizes, int n_in, void* d_out, int out_size, void* d_ws, size_t ws_size, hipStream_t stream) {
    static int grid_blocks = 0;
    if (grid_blocks == 0) {
        if (n_in != 21 || ws_size < WS_END + 256) { fprintf(stderr, "kernel_launch: unexpected n_in %d / ws_size %zu (need %zu)\n", n_in, ws_size, (size_t)WS_END); grid_blocks = -1; return; }
        int dev = 0, cus = 0, per_cu = 0;
        hipGetDevice(&dev); hipDeviceGetAttribute(&cus, hipDeviceAttributeMultiprocessorCount, dev);
        if (hipFuncSetAttribute((const void*)fwd_megakernel, hipFuncAttributeMaxDynamicSharedMemorySize, LDS_BYTES) != hipSuccess) fprintf(stderr, "kernel_launch: hipFuncSetAttribute failed\n");
        if (hipOccupancyMaxActiveBlocksPerMultiprocessor(&per_cu, (const void*)fwd_megakernel, 512, LDS_BYTES) != hipSuccess || per_cu < 1) { fprintf(stderr, "kernel_launch: occupancy query gave %d\n", per_cu); per_cu = 1; }
        (void)hipGetLastError();
        grid_blocks = cus * per_cu;
        if (grid_blocks > 256) grid_blocks = 256;
    }
    if (grid_blocks < 0) return;
    Params p{};
    const float** pp = (const float**)&p;
    for (int i = 0; i < 21; ++i) pp[i] = (const float*)d_in[i];
    p.out = (float*)d_out; p.ws = (unsigned char*)d_ws;
    void* args[] = {&p};
    hipError_t e = hipLaunchCooperativeKernel((const void*)fwd_megakernel, dim3(grid_blocks), dim3(512), args, LDS_BYTES, stream);
    if (e != hipSuccess) fprintf(stderr, "cooperative launch failed: %s (grid %d)\n", hipGetErrorString(e), grid_blocks);
}
```

```cpp
#include <hip/hip_runtime.h>
#include <hip/hip_cooperative_groups.h>
#include <cstdio>
#include <cstdint>
namespace cg = cooperative_groups;

#define LAS __attribute__((address_space(3)))
typedef unsigned short bf16_t;
typedef short bf16x8 __attribute__((ext_vector_type(8)));
typedef float f32x4 __attribute__((ext_vector_type(4)));
typedef float f32x2 __attribute__((ext_vector_type(2)));
typedef unsigned u32x4 __attribute__((ext_vector_type(4)));
typedef unsigned u32x2 __attribute__((ext_vector_type(2)));
typedef _Float16 h16x2 __attribute__((ext_vector_type(2)));

constexpr int D = 2048, SEQ = 16384, NBATCH = 2, DEPTH = 4;
constexpr int NREAL = NBATCH * SEQ;
constexpr int NMETA = 16;
constexpr int NROWS = NREAL + NMETA;
constexpr int MPAD = 33024;
constexpr int NCOLS = 16576, NP = 16640;
constexpr int DA = 1024, DB = 2048, NHEAD = 32, LORA = 96;
constexpr int PC_XIN = 0, PC_BG = 1024, PC_CG = 2048, PC_ZA = 3072, PC_R = 4096, PC_K = 6144, PC_V = 8192, PC_Z = 10240,
              PC_GA = 12288, PC_GB = 14336, PC_WLO = 16384, PC_ALO = 16480;
constexpr float LN_EPS = 1e-5f, GN_EPS = 6.4e-4f;
constexpr float ALPHA = 1.6817928305074292f;

constexpr size_t al256(size_t x) { return (x + 255) & ~(size_t)255; }
constexpr size_t WS_WIN = 0;
constexpr size_t WS_WA = al256(WS_WIN + (size_t)NP * D * 2);
constexpr size_t WS_WB = al256(WS_WA + (size_t)DEPTH * D * DA * 2);
constexpr size_t WS_WO = al256(WS_WB + (size_t)DEPTH * D * DB * 2);
constexpr size_t WS_WL = al256(WS_WO + (size_t)DEPTH * D * D * 2);
constexpr size_t WS_HF = al256(WS_WL + (size_t)DEPTH * 4096 * 256 * 2);
constexpr size_t WS_HB = al256(WS_HF + (size_t)MPAD * D * 4);
constexpr size_t WS_P = al256(WS_HB + (size_t)MPAD * D * 2);
constexpr size_t WS_CO = al256(WS_P + (size_t)MPAD * NP * 2);
constexpr size_t WS_SB = al256(WS_CO + (size_t)MPAD * DA * 2);
constexpr size_t WS_AB = al256(WS_SB + (size_t)MPAD * DB * 2);
constexpr size_t WS_AL = al256(WS_AB + (size_t)MPAD * DB * 2);
constexpr size_t WS_BON = al256(WS_AL + (size_t)MPAD * 256 * 2);
constexpr size_t WS_END = al256(WS_BON + (size_t)MPAD * 32 * 4);

struct Params {
    const float *x, *meta, *emb_g, *emb_b, *w_in, *conv_w, *w_a, *mu, *w0, *w2, *a0, *a2, *kks, *kas, *rk, *gn_g, *gn_b, *w_b, *w_out, *ln_g, *ln_b;
    float* out; unsigned char* ws;
};

__device__ __forceinline__ unsigned cvt_pk_bf16(float lo, float hi) { unsigned r; asm volatile("v_cvt_pk_bf16_f32 %0, %1, %2" : "=v"(r) : "v"(lo), "v"(hi)); return r; }
__device__ __forceinline__ float bf_lo(unsigned w) { return __uint_as_float(w << 16); }
__device__ __forceinline__ float bf_hi(unsigned w) { return __uint_as_float(w & 0xffff0000u); }
__device__ __forceinline__ void unpack8(const u32x4 w, float (&f)[8]) {
    f[0] = bf_lo(w.x); f[1] = bf_hi(w.x); f[2] = bf_lo(w.y); f[3] = bf_hi(w.y); f[4] = bf_lo(w.z); f[5] = bf_hi(w.z); f[6] = bf_lo(w.w); f[7] = bf_hi(w.w);
}
__device__ __forceinline__ u32x4 pack8(const float (&f)[8]) {
    u32x4 w; w.x = cvt_pk_bf16(f[0], f[1]); w.y = cvt_pk_bf16(f[2], f[3]); w.z = cvt_pk_bf16(f[4], f[5]); w.w = cvt_pk_bf16(f[6], f[7]); return w;
}
__device__ __forceinline__ unsigned pack_h2(float a, float b) { h16x2 v; v.x = (_Float16)a; v.y = (_Float16)b; return __builtin_bit_cast(unsigned, v); }
__device__ __forceinline__ float h_lo(unsigned w) { return (float)__builtin_bit_cast(_Float16, (unsigned short)(w & 0xffffu)); }
__device__ __forceinline__ float h_hi(unsigned w) { return (float)__builtin_bit_cast(_Float16, (unsigned short)(w >> 16)); }
__device__ __forceinline__ void unpack8h(const u32x4 w, float (&f)[8]) {
    f[0] = h_lo(w.x); f[1] = h_hi(w.x); f[2] = h_lo(w.y); f[3] = h_hi(w.y); f[4] = h_lo(w.z); f[5] = h_hi(w.z); f[6] = h_lo(w.w); f[7] = h_hi(w.w);
}
__device__ __forceinline__ float sigmoidf_(float v) { return __builtin_amdgcn_rcpf(1.0f + __expf(-v)); }
__device__ __forceinline__ float siluf_(float v) { return v * sigmoidf_(v); }
template <int CTRL> __device__ __forceinline__ float dpp_mov(float x) {
    return __builtin_bit_cast(float, __builtin_amdgcn_mov_dpp(__builtin_bit_cast(int, x), CTRL, 0xf, 0xf, true));
}
__device__ __forceinline__ float allred8(float x) { x += dpp_mov<0xB1>(x); x += dpp_mov<0x4E>(x); x += dpp_mov<0x141>(x); return x; }
__device__ __forceinline__ float allred16(float x) { x = allred8(x); x += dpp_mov<0x128>(x); return x; }
__device__ __forceinline__ float wave_sum(float v) {
#pragma unroll
    for (int o = 1; o < 64; o <<= 1) v += __shfl_xor(v, o);
    return v;
}
__device__ __forceinline__ int prev_row(int r) { if (r >= NREAL) return r == NREAL ? -1 : r - 1; return (r & (SEQ - 1)) ? r - 1 : NROWS - 1; }

#ifndef GEMM_SP2
#define GEMM_SP2 true
#endif
#ifndef GEMM_ALIGN
#define GEMM_ALIGN true
#endif
namespace pg8 {
constexpr int BM = 256, BK = 64, HALF = 128, HTB = HALF * BK * 2, STAGE_BYTES = 8 * HTB, NXCD = 8, WGM = 4;
__host__ __device__ __forceinline__ int lds_byte(int r, int c) { const int st = (r >> 4) * 2 + (c >> 5), rr = r & 15, cc = c & 31, ob = rr * 64 + cc * 2; return st * 1024 + (ob ^ (((ob >> 9) & 1) << 5)); }
__host__ __device__ __forceinline__ void stage_rc(int b, int& R, int& C) { const int st = b / 1024, sb = b % 1024, swz = sb ^ (((sb >> 9) & 1) << 5); R = (st >> 1) * 16 + swz / 64; C = (st & 1) * 32 + (swz % 64) / 2; }
__host__ __device__ __forceinline__ int perm32(int rho) { const int n = rho >> 4, i = rho & 15; return 8 * (i >> 2) + 4 * n + (i & 3); }
struct Unit { int pm, pn; };
struct Gemm { const bf16_t* A; const bf16_t* Bt; int M, N, K; };
struct StaticOrder {
    int nM, nN, nwg, G, c;
    __device__ void init(int M, int N, int G_, int c_) { nM = M / BM; nN = N / BM; nwg = nM * nN; G = G_; c = c_; }
    __device__ bool next(int i, Unit& u) const {
        const long L = (long)i * G + c; if (L >= nwg) return false;
        int wgid = (int)L; { const int q = nwg / NXCD, r = nwg % NXCD, xcd = wgid % NXCD, off = wgid / NXCD; wgid = (xcd < r ? xcd * (q + 1) : r * (q + 1) + (xcd - r) * q) + off; }
        const int nig = WGM * nN, gid = wgid / nig, fm = gid * WGM, gsz = (nM - fm) < WGM ? (nM - fm) : WGM;
        u.pm = fm + ((wgid % nig) % gsz); u.pn = (wgid % nig) / gsz; return true;
    }
    __device__ __forceinline__ void a_ready(const Unit&) const {}
    __device__ __forceinline__ void done(const Unit&) const {}
};

template <class Epi, class Sched, bool ALIGN_EPI = false, bool SP2 = false>
__device__ __forceinline__ void gemm_phase(LAS unsigned char* lds, const Gemm g, const Sched& S, const Epi& E, const int tid) {
    const int wid = __builtin_amdgcn_readfirstlane(tid >> 6), lane = tid & 63, wr = wid >> 2, wc = wid & 3, fr = lane & 15, fq = lane >> 4;
    int K = g.K; asm volatile("" : "+s"(K)); const int nt = K / BK;
    unsigned voffA[2], voffB[2];
#pragma unroll
    for (int i = 0; i < 2; ++i) { int R, C; stage_rc(tid * 16 + i * 8192, R, C); const int Rb = Epi::PERM ? ((R & ~31) + perm32(R & 31)) : R;
        voffA[i] = (unsigned)(R * K + C) * 2u; voffB[i] = (unsigned)(Rb * K + C) * 2u; }
    const size_t kstep = (size_t)(BK * 2);
    const size_t hstep = (size_t)HALF * K * 2;
    const size_t tstep = 2 * hstep;
    const unsigned ldsw = (unsigned)wid * 1024u;
    const int aoff = lds_byte(wr * 64 + fr, fq * 8), boff = lds_byte(wc * 32 + fr, fq * 8);
#define PG8_SA(b, h) (((b) * 2 + (h)) * HTB)
#define PG8_SB(b, h) ((4 + (b) * 2 + (h)) * HTB)
#define PG8_STAGE(bufoff, gbase, voff) do { _Pragma("unroll") for (int _i = 0; _i < 2; ++_i) \
        __builtin_amdgcn_global_load_lds((const unsigned*)((const char*)(gbase) + (voff)[_i]), (LAS unsigned*)(lds + (bufoff) + ldsw + _i * 8192), 16, 0, 0); } while (0)
#define PG8_LDA(dst, b, h) do { _Pragma("unroll") for (int m = 0; m < 4; ++m) _Pragma("unroll") for (int k = 0; k < 2; ++k) dst[m][k] = *(const LAS bf16x8*)(lds + PG8_SA(b, h) + aoff + m * 2048 + k * 1024); } while (0)
#define PG8_LDB(dst, b, h) do { _Pragma("unroll") for (int n = 0; n < 2; ++n) _Pragma("unroll") for (int k = 0; k < 2; ++k) dst[n][k] = *(const LAS bf16x8*)(lds + PG8_SB(b, h) + boff + n * 2048 + k * 1024); } while (0)
#define PG8_MMA(ai, bj, At, Bt) do { __builtin_amdgcn_s_setprio(1); _Pragma("unroll") for (int m = 0; m < 4; ++m) _Pragma("unroll") for (int n = 0; n < 2; ++n) _Pragma("unroll") for (int k = 0; k < 2; ++k) \
        acc[ai][bj][m][n] = __builtin_amdgcn_mfma_f32_16x16x32_bf16(Bt[n][k], At[m][k], acc[ai][bj][m][n], 0, 0, 0); __builtin_amdgcn_s_setprio(0); } while (0)
#define PG8_WAIT_V(n) asm volatile("s_waitcnt vmcnt(" #n ")" ::: "memory")
#define PG8_WAIT_L(n) asm volatile("s_waitcnt lgkmcnt(" #n ")" ::: "memory")
#define PG8_BAR __builtin_amdgcn_s_barrier()
#define PG8_SCHED __builtin_amdgcn_sched_barrier(0)
    Unit cur, nxt; int ui = 0;
    if (!S.next(0, cur)) return;
    f32x4 acc[2][2][4][2];
#pragma unroll
    for (int a = 0; a < 2; ++a)
#pragma unroll
        for (int b = 0; b < 2; ++b)
#pragma unroll
            for (int m = 0; m < 4; ++m)
#pragma unroll
                for (int n = 0; n < 2; ++n) acc[a][b][m][n] = (f32x4){0.f, 0.f, 0.f, 0.f};
    bf16x8 At[4][2], B0[2][2], B1[2][2];
    const char* cA = (const char*)g.A + (size_t)cur.pm * tstep; const char* cB = (const char*)g.Bt + (size_t)cur.pn * tstep;
    S.a_ready(cur);
    if constexpr (SP2) {
        PG8_STAGE(PG8_SB(0, 0), cB, voffB); PG8_STAGE(PG8_SB(0, 1), cB + hstep, voffB); PG8_STAGE(PG8_SA(0, 0), cA, voffA); PG8_STAGE(PG8_SA(0, 1), cA + hstep, voffA);
        if (wr == 1) PG8_BAR;
        PG8_WAIT_V(2); PG8_BAR;
        PG8_STAGE(PG8_SB(1, 0), cB + kstep, voffB); PG8_STAGE(PG8_SA(1, 0), cA + kstep, voffA); PG8_STAGE(PG8_SB(1, 1), cB + hstep + kstep, voffB);
        PG8_WAIT_V(6); PG8_BAR;
    } else {
        PG8_STAGE(PG8_SB(0, 0), cB, voffB); PG8_STAGE(PG8_SA(0, 0), cA, voffA); PG8_STAGE(PG8_SB(0, 1), cB + hstep, voffB); PG8_STAGE(PG8_SA(0, 1), cA + hstep, voffA);
        if (wr == 1) PG8_BAR;
        PG8_WAIT_V(4); PG8_BAR;
        PG8_STAGE(PG8_SB(1, 0), cB + kstep, voffB); PG8_STAGE(PG8_SA(1, 0), cA + kstep, voffA); PG8_STAGE(PG8_SB(1, 1), cB + hstep + kstep, voffB);
        PG8_WAIT_V(6); PG8_BAR;
    }
    for (;;) {
        const bool has_next = S.next(ui + 1, nxt);
        const char* nA = has_next ? (const char*)g.A + (size_t)nxt.pm * tstep : cA; const char* nB = has_next ? (const char*)g.Bt + (size_t)nxt.pn * tstep : cB;
        for (int t = 0; t < nt; t += 2) {
            const bool last = (t == nt - 2);
            const char* a1 = cA + (size_t)(t + 1) * kstep;
            const char* a2 = last ? nA : cA + (size_t)(t + 2) * kstep; const char* b2 = last ? nB : cB + (size_t)(t + 2) * kstep;
            const char* a3 = a2 + kstep; const char* b3 = b2 + kstep;
            if (last && has_next) S.a_ready(nxt);
            if constexpr (SP2) {
            PG8_LDB(B0, 0, 0); PG8_LDB(B1, 0, 1); PG8_SCHED; PG8_LDA(At, 0, 0); PG8_STAGE(PG8_SA(1, 1), a1 + hstep, voffA);
            PG8_WAIT_V(8); PG8_WAIT_L(0); PG8_BAR; PG8_MMA(0, 0, At, B0); PG8_MMA(0, 1, At, B1); PG8_BAR; PG8_SCHED;
            PG8_LDA(At, 0, 1); PG8_STAGE(PG8_SB(0, 0), b2, voffB); PG8_STAGE(PG8_SB(0, 1), b2 + hstep, voffB); PG8_STAGE(PG8_SA(0, 0), a2, voffA);
            PG8_WAIT_V(8); PG8_WAIT_L(0); PG8_BAR; PG8_MMA(1, 0, At, B0); PG8_MMA(1, 1, At, B1); PG8_BAR; PG8_SCHED;
            PG8_LDB(B0, 1, 0); PG8_LDB(B1, 1, 1); PG8_SCHED; PG8_LDA(At, 1, 0); PG8_STAGE(PG8_SA(0, 1), a2 + hstep, voffA);
            PG8_WAIT_V(8); PG8_WAIT_L(0); PG8_BAR; PG8_MMA(0, 0, At, B0); PG8_MMA(0, 1, At, B1); PG8_BAR; PG8_SCHED;
            PG8_LDA(At, 1, 1); PG8_STAGE(PG8_SB(1, 0), b3, voffB); PG8_STAGE(PG8_SB(1, 1), b3 + hstep, voffB); PG8_STAGE(PG8_SA(1, 0), a3, voffA);
            PG8_WAIT_V(8); PG8_WAIT_L(0); PG8_BAR; PG8_MMA(1, 0, At, B0); PG8_MMA(1, 1, At, B1); PG8_BAR; PG8_SCHED;
            } else {
            PG8_LDB(B0, 0, 0); PG8_SCHED; PG8_LDA(At, 0, 0); PG8_STAGE(PG8_SA(1, 1), a1 + hstep, voffA);
            PG8_WAIT_L(8); PG8_BAR; PG8_WAIT_L(0); PG8_MMA(0, 0, At, B0); PG8_BAR; PG8_SCHED;
            PG8_LDB(B1, 0, 1); PG8_STAGE(PG8_SB(0, 0), b2, voffB);
            PG8_BAR; PG8_WAIT_L(0); PG8_MMA(0, 1, At, B1); PG8_BAR;
            PG8_LDA(At, 0, 1); PG8_STAGE(PG8_SA(0, 0), a2, voffA);
            PG8_BAR; PG8_WAIT_L(0); PG8_MMA(1, 0, At, B0); PG8_BAR; PG8_SCHED;
            PG8_STAGE(PG8_SB(0, 1), b2 + hstep, voffB);
            PG8_WAIT_V(6); PG8_BAR; PG8_MMA(1, 1, At, B1); PG8_BAR;
            PG8_LDB(B0, 1, 0); PG8_SCHED; PG8_LDA(At, 1, 0); PG8_STAGE(PG8_SA(0, 1), a2 + hstep, voffA);
            PG8_WAIT_L(8); PG8_BAR; PG8_WAIT_L(0); PG8_MMA(0, 0, At, B0); PG8_BAR; PG8_SCHED;
            PG8_LDB(B1, 1, 1); PG8_STAGE(PG8_SB(1, 0), b3, voffB);
            PG8_BAR; PG8_WAIT_L(0); PG8_MMA(0, 1, At, B1); PG8_BAR;
            PG8_LDA(At, 1, 1); PG8_STAGE(PG8_SA(1, 0), a3, voffA);
            PG8_BAR; PG8_WAIT_L(0); PG8_MMA(1, 0, At, B0); PG8_BAR; PG8_SCHED;
            PG8_STAGE(PG8_SB(1, 1), b3 + hstep, voffB);
            PG8_WAIT_V(6); PG8_BAR; PG8_MMA(1, 1, At, B1); PG8_BAR;
            }
        }
        if constexpr (ALIGN_EPI) { if (wr == 0) PG8_BAR; }
        E(acc, cur, wr, wc, fr, fq); S.done(cur);
        if (!has_next) break;
#pragma unroll
        for (int a = 0; a < 2; ++a)
#pragma unroll
            for (int b = 0; b < 2; ++b)
#pragma unroll
                for (int m = 0; m < 4; ++m)
#pragma unroll
                    for (int n = 0; n < 2; ++n) acc[a][b][m][n] = (f32x4){0.f, 0.f, 0.f, 0.f};
        cur = nxt; cA = nA; cB = nB; ++ui;
        if constexpr (ALIGN_EPI) { if (wr == 1) PG8_BAR; }
    }
    PG8_WAIT_V(0);
    if constexpr (!ALIGN_EPI) { if (wr == 0) PG8_BAR; }
    PG8_BAR;
#undef PG8_SA
#undef PG8_SB
#undef PG8_STAGE
#undef PG8_LDA
#undef PG8_LDB
#undef PG8_MMA
#undef PG8_WAIT_V
#undef PG8_WAIT_L
#undef PG8_BAR
#undef PG8_SCHED
}
template <class Epi>
__device__ __forceinline__ void gemm_run(LAS unsigned char* lds, const Gemm g, const StaticOrder& S, const Epi& E, const int tid) { gemm_phase<Epi, StaticOrder, GEMM_ALIGN, GEMM_SP2>(lds, g, S, E, tid); }
}

struct EpiP {
    static constexpr bool PERM = true;
    bf16_t* O;
    __device__ __forceinline__ void operator()(const f32x4 (&acc)[2][2][4][2], const pg8::Unit& u, int wr, int wc, int fr, int fq) const {
        const int row0 = u.pm * 256 + wr * 64 + fr, col0 = u.pn * 256 + wc * 32 + 8 * fq;
#pragma unroll
        for (int ai = 0; ai < 2; ++ai)
#pragma unroll
            for (int m = 0; m < 4; ++m) { bf16_t* rowp = O + (size_t)(row0 + ai * 128 + m * 16) * NP + col0;
#pragma unroll
                for (int bj = 0; bj < 2; ++bj) { const f32x4 v0 = acc[ai][bj][m][0], v1 = acc[ai][bj][m][1];
                    u32x4 w; w.x = cvt_pk_bf16(v0[0], v0[1]); w.y = cvt_pk_bf16(v0[2], v0[3]); w.z = cvt_pk_bf16(v1[0], v1[1]); w.w = cvt_pk_bf16(v1[2], v1[3]);
                    *(u32x4*)(rowp + bj * 128) = w; } }
    }
};
struct EpiLora {
    static constexpr bool PERM = true;
    unsigned short *X, *Ab; const float *w0, *a0;
    __device__ __forceinline__ void operator()(const f32x4 (&acc)[2][2][4][2], const pg8::Unit& u, int wr, int wc, int fr, int fq) const {
        const int row0 = u.pm * 256 + wr * 64 + fr; const int colt = u.pn * 256; const bool isA = colt >= 2048;
        unsigned short* base = isA ? Ab : X; const float* bias = isA ? a0 : w0; const float scale = isA ? 1.0f : 0.60653065971f;
        const int cc = (colt & 2047) + wc * 32 + 8 * fq;
        f32x4 bv[2][2];
#pragma unroll
        for (int bj = 0; bj < 2; ++bj) { bv[bj][0] = *(const f32x4*)(bias + cc + bj * 128); bv[bj][1] = *(const f32x4*)(bias + cc + bj * 128 + 4); }
#pragma unroll
        for (int ai = 0; ai < 2; ++ai)
#pragma unroll
            for (int m = 0; m < 4; ++m) { unsigned short* rowp = base + (size_t)(row0 + ai * 128 + m * 16) * DB + cc;
#pragma unroll
                for (int bj = 0; bj < 2; ++bj) { const f32x4 v0 = acc[ai][bj][m][0] + bv[bj][0], v1 = acc[ai][bj][m][1] + bv[bj][1];
                    u32x4 w; w.x = pack_h2(scale * sigmoidf_(v0[0]), scale * sigmoidf_(v0[1])); w.y = pack_h2(scale * sigmoidf_(v0[2]), scale * sigmoidf_(v0[3]));
                    w.z = pack_h2(scale * sigmoidf_(v1[0]), scale * sigmoidf_(v1[1])); w.w = pack_h2(scale * sigmoidf_(v1[2]), scale * sigmoidf_(v1[3]));
                    *(u32x4*)(rowp + bj * 128) = w; } }
    }
};
template <bool ACCUM> struct EpiY {
    static constexpr bool PERM = true;
    bf16_t* Mg; const bf16_t* P; int gcol;
    __device__ __forceinline__ void operator()(const f32x4 (&acc)[2][2][4][2], const pg8::Unit& u, int wr, int wc, int fr, int fq) const {
        const int row0 = u.pm * 256 + wr * 64 + fr, col0 = u.pn * 256 + wc * 32 + 8 * fq;
#pragma unroll
        for (int ai = 0; ai < 2; ++ai)
#pragma unroll
            for (int m = 0; m < 4; ++m) { const int row = row0 + ai * 128 + m * 16;
#pragma unroll
                for (int bj = 0; bj < 2; ++bj) { const int col = col0 + bj * 128;
                    const u32x4 gw = *(const u32x4*)(P + (size_t)row * NP + gcol + col);
                    float g[8], o[8]; unpack8(gw, g);
                    const f32x4 v0 = acc[ai][bj][m][0], v1 = acc[ai][bj][m][1];
#pragma unroll
                    for (int e = 0; e < 4; ++e) { o[e] = sigmoidf_(g[e]) * v0[e]; o[4 + e] = sigmoidf_(g[4 + e]) * v1[e]; }
                    bf16_t* dst = Mg + (size_t)row * D + col;
                    if (ACCUM) { const u32x4 ow = *(const u32x4*)dst; float od[8]; unpack8(ow, od);
#pragma unroll
                        for (int e = 0; e < 8; ++e) o[e] += od[e]; }
                    *(u32x4*)dst = pack8(o); } }
    }
};
struct EpiOut {
    static constexpr bool PERM = false;
    float* H;
    __device__ __forceinline__ void operator()(const f32x4 (&acc)[2][2][4][2], const pg8::Unit& u, int wr, int wc, int fr, int fq) const {
        const int row0 = u.pm * 256 + wr * 64 + fr, col0 = u.pn * 256 + wc * 32 + 4 * fq;
#pragma unroll
        for (int ai = 0; ai < 2; ++ai)
#pragma unroll
            for (int m = 0; m < 4; ++m) { float* rowp = H + (size_t)(row0 + ai * 128 + m * 16) * D + col0;
#pragma unroll
                for (int bj = 0; bj < 2; ++bj)
#pragma unroll
                    for (int n = 0; n < 2; ++n) { f32x4* ptr = (f32x4*)(rowp + bj * 128 + n * 16); *ptr = ALPHA * (*ptr) + acc[ai][bj][m][n]; } }
    }
};


template <int KS  >
__device__ __forceinline__ f32x4 meta_dot(const bf16_t* A  , const bf16_t* Bt  , int K, int ct, int k0, int fr, int fq) {
    f32x4 acc = (f32x4){0.f, 0.f, 0.f, 0.f};
    const bf16_t* ap = A + (size_t)fr * K + k0 + fq * 8; const bf16_t* bp = Bt + (size_t)(ct * 16 + fr) * K + k0 + fq * 8;
    bf16x8 a[KS / 32], b[KS / 32];
#pragma unroll
    for (int i = 0; i < KS / 32; ++i) { a[i] = *(const bf16x8*)(ap + i * 32); b[i] = *(const bf16x8*)(bp + i * 32); }
#pragma unroll
    for (int i = 0; i < KS / 32; ++i) acc = __builtin_amdgcn_mfma_f32_16x16x32_bf16(b[i], a[i], acc, 0, 0, 0);
    return acc;
}
__device__ __forceinline__ void meta_p4(const Params& P, int l, LAS unsigned char* lds, int wid, int lane) {
    if (blockIdx.x >= D / 16) return;
    const int ct = blockIdx.x, fr = lane & 15, fq = lane >> 4;
    const f32x4 ya = meta_dot<DA / 8>((const bf16_t*)(P.ws + WS_CO) + (size_t)NREAL * DA, (const bf16_t*)(P.ws + WS_WA) + (size_t)l * D * DA, DA, ct, wid * (DA / 8), fr, fq);
    const f32x4 yb = meta_dot<DB / 8>((const bf16_t*)(P.ws + WS_SB) + (size_t)NREAL * DB, (const bf16_t*)(P.ws + WS_WB) + (size_t)l * D * DB, DB, ct, wid * (DB / 8), fr, fq);
    LAS f32x4* red = (LAS f32x4*)lds;
    red[(wid * 2 + 0) * 64 + lane] = ya; red[(wid * 2 + 1) * 64 + lane] = yb;
    __syncthreads();
    if (wid == 0) {
        f32x4 sa = red[lane], sb2 = red[64 + lane];
#pragma unroll
        for (int w = 1; w < 8; ++w) { sa += red[(w * 2) * 64 + lane]; sb2 += red[(w * 2 + 1) * 64 + lane]; }
        const int row = NREAL + fr, c0 = ct * 16 + 4 * fq;
        const bf16_t* pr = (const bf16_t*)(P.ws + WS_P) + (size_t)row * NP;
        const u32x2 ga = *(const u32x2*)(pr + PC_GA + c0), gb = *(const u32x2*)(pr + PC_GB + c0);
        const float o0 = sigmoidf_(bf_lo(ga.x)) * sa[0] + sigmoidf_(bf_lo(gb.x)) * sb2[0], o1 = sigmoidf_(bf_hi(ga.x)) * sa[1] + sigmoidf_(bf_hi(gb.x)) * sb2[1];
        const float o2 = sigmoidf_(bf_lo(ga.y)) * sa[2] + sigmoidf_(bf_lo(gb.y)) * sb2[2], o3 = sigmoidf_(bf_hi(ga.y)) * sa[3] + sigmoidf_(bf_hi(gb.y)) * sb2[3];
        u32x2 w; w.x = cvt_pk_bf16(o0, o1); w.y = cvt_pk_bf16(o2, o3);
        *(u32x2*)((bf16_t*)(P.ws + WS_HB) + (size_t)row * D + c0) = w;
    }
}
__device__ __forceinline__ void meta_p5(const Params& P, int l, LAS unsigned char* lds, int wid, int lane) {
    if (blockIdx.x >= D / 16) return;
    const int ct = blockIdx.x, fr = lane & 15, fq = lane >> 4;
    const f32x4 acc = meta_dot<D / 8>((const bf16_t*)(P.ws + WS_HB) + (size_t)NREAL * D, (const bf16_t*)(P.ws + WS_WO) + (size_t)l * D * D, D, ct, wid * (D / 8), fr, fq);
    LAS f32x4* red = (LAS f32x4*)lds;
    red[wid * 64 + lane] = acc;
    __syncthreads();
    if (wid == 0) {
        f32x4 sa = red[lane];
#pragma unroll
        for (int w = 1; w < 8; ++w) sa += red[w * 64 + lane];
        f32x4* ptr = (f32x4*)((float*)(P.ws + WS_HF) + (size_t)(NREAL + fr) * D + ct * 16 + 4 * fq);
        *ptr = ALPHA * (*ptr) + sa;
    }
}

__device__ __forceinline__ void transpose_item(const float* W, int ldw, int src_n0, int k0, bf16_t* WT, int K, int dst_n0, LAS float* scr, int lane) {
    if (src_n0 >= 0) {
        f32x4 v[8]; const int n4 = (lane & 7) * 4;
#pragma unroll
        for (int i = 0; i < 8; ++i) v[i] = *(const f32x4*)(W + (size_t)(k0 + (lane >> 3) + 8 * i) * ldw + src_n0 + n4);
#pragma unroll
        for (int i = 0; i < 8; ++i) { LAS float* d = scr + ((lane >> 3) + 8 * i) * 33 + n4; d[0] = v[i].x; d[1] = v[i].y; d[2] = v[i].z; d[3] = v[i].w; }
    }
    asm volatile("s_waitcnt lgkmcnt(0)" ::: "memory");
    const int c = lane & 7;
#pragma unroll
    for (int j = 0; j < 4; ++j) { const int n = (lane >> 3) + 8 * j; const LAS float* s = scr + (8 * c) * 33 + n;
        u32x4 o = (u32x4){0u, 0u, 0u, 0u};
        if (src_n0 >= 0) { o.x = cvt_pk_bf16(s[0 * 33], s[1 * 33]); o.y = cvt_pk_bf16(s[2 * 33], s[3 * 33]); o.z = cvt_pk_bf16(s[4 * 33], s[5 * 33]); o.w = cvt_pk_bf16(s[6 * 33], s[7 * 33]); }
        *(u32x4*)(WT + (size_t)(dst_n0 + n) * K + k0 + 8 * c) = o; }
    asm volatile("s_waitcnt lgkmcnt(0)" ::: "memory");
}
__device__ __forceinline__ int win_src_col(int j) { return j < 12288 ? j : (j < 16384 ? j + 192 : (j < 16576 ? j - 4096 : -1)); }

__device__ __forceinline__ void convert_win(const Params& P, int l, LAS unsigned char* lds, int gw, int ngw, int wid, int lane) {
    LAS float* scr = (LAS float*)(lds + wid * 8448);
    const float* W = P.w_in + (size_t)l * D * NCOLS; bf16_t* WT = (bf16_t*)(P.ws + WS_WIN);
    constexpr int NBLK = NP / 32;
    for (int it = gw; it < (D / 64) * NBLK; it += ngw) { const int kb = it / NBLK, nb = it % NBLK;
        transpose_item(W, NCOLS, win_src_col(nb * 32), kb * 64, WT, D, nb * 32, scr, lane); }
}
__device__ __forceinline__ void convert_small(const Params& P, LAS unsigned char* lds, int gw, int ngw, int wid, int lane) {
    LAS float* scr = (LAS float*)(lds + wid * 8448);
    constexpr int IA = (DA / 64) * (D / 32), IB = (DB / 64) * (D / 32), IO = (D / 64) * (D / 32), IL = IA + IB + IO;
    for (int it = gw; it < DEPTH * IL; it += ngw) { const int l = it / IL; int r = it % IL;
        if (r < IA) { transpose_item(P.w_a + (size_t)l * DA * D, D, (r % (D / 32)) * 32, (r / (D / 32)) * 64, (bf16_t*)(P.ws + WS_WA) + (size_t)l * D * DA, DA, (r % (D / 32)) * 32, scr, lane); continue; } r -= IA;
        if (r < IB) { transpose_item(P.w_b + (size_t)l * DB * D, D, (r % (D / 32)) * 32, (r / (D / 32)) * 64, (bf16_t*)(P.ws + WS_WB) + (size_t)l * D * DB, DB, (r % (D / 32)) * 32, scr, lane); continue; } r -= IB;
        transpose_item(P.w_out + (size_t)l * D * D, D, (r % (D / 32)) * 32, (r / (D / 32)) * 64, (bf16_t*)(P.ws + WS_WO) + (size_t)l * D * D, D, (r % (D / 32)) * 32, scr, lane); }
    bf16_t* WL = (bf16_t*)(P.ws + WS_WL);
    const size_t tot = (size_t)DEPTH * 4096 * 32;
    for (size_t it = (size_t)gw * 64 + lane; it < tot; it += (size_t)ngw * 64) {
        const int n = (int)(it % 4096); const int kc = (int)((it / 4096) % 32) * 8; const int l = (int)(it / (4096 * 32));
        float f[8];
#pragma unroll
        for (int e = 0; e < 8; ++e) { const int k = kc + e; float v = 0.f;
            if (n < 2048) { if (k < LORA) v = P.w2[((size_t)l * LORA + k) * DB + n]; }
            else { if (k >= 128 && k < 128 + LORA) v = P.a2[((size_t)l * LORA + (k - 128)) * DB + (n - 2048)]; }
            f[e] = v; }
        *(u32x4*)(WL + ((size_t)l * 4096 + n) * 256 + kc) = pack8(f);
    }
}
__device__ __forceinline__ void ln_row(const float* src, const float* g, const float* b, float* dstf, bf16_t* dstb, int lane) {
    const f32x4* xr = (const f32x4*)src + lane;
    f32x4 v[8]; float s = 0.f;
#pragma unroll
    for (int j = 0; j < 8; ++j) { v[j] = xr[64 * j]; s += (v[j].x + v[j].y) + (v[j].z + v[j].w); }
    const float mean = wave_sum(s) * (1.f / D); float s2 = 0.f;
#pragma unroll
    for (int j = 0; j < 8; ++j) { v[j] = v[j] - mean; s2 += (v[j].x * v[j].x + v[j].y * v[j].y) + (v[j].z * v[j].z + v[j].w * v[j].w); }
    const float rstd = 1.f / sqrtf(wave_sum(s2) * (1.f / D) + LN_EPS);
#pragma unroll
    for (int j = 0; j < 8; ++j) { const f32x4 gg = ((const f32x4*)g)[lane + 64 * j], bb = ((const f32x4*)b)[lane + 64 * j];
        const f32x4 o = v[j] * rstd * gg + bb;
        if (dstf) ((f32x4*)dstf)[lane + 64 * j] = o;
        if (dstb) { u32x2 w; w.x = cvt_pk_bf16(o.x, o.y); w.y = cvt_pk_bf16(o.z, o.w); ((u32x2*)dstb)[lane + 64 * j] = w; } }
}
__device__ __forceinline__ void embed_phase(const Params& P, int gw, int ngw, int lane) {
    float* hf = (float*)(P.ws + WS_HF); bf16_t* hb = (bf16_t*)(P.ws + WS_HB);
    for (int r = gw; r < MPAD; r += ngw) {
        if (r < NROWS) { const float* src = r < NREAL ? P.x + (size_t)r * D : P.meta + (size_t)(r - NREAL) * D;
            ln_row(src, P.emb_g, P.emb_b, hf + (size_t)r * D, hb + (size_t)r * D, lane); }
        else {
#pragma unroll
            for (int j = 0; j < 8; ++j) { ((f32x4*)(hf + (size_t)r * D))[lane + 64 * j] = (f32x4){0.f, 0.f, 0.f, 0.f}; ((u32x2*)(hb + (size_t)r * D))[lane + 64 * j] = (u32x2){0u, 0u}; }
        }
    }
}
__device__ __forceinline__ void ln_phase(const Params& P, int l, int gw, int ngw, int lane) {
    float* hf = (float*)(P.ws + WS_HF); bf16_t* hb = (bf16_t*)(P.ws + WS_HB);
    const float* g = P.ln_g + (size_t)l * D; const float* b = P.ln_b + (size_t)l * D;
    if (l == DEPTH - 1) { for (int r = gw; r < NREAL; r += ngw) ln_row(hf + (size_t)r * D, g, b, P.out + (size_t)r * D, nullptr, lane); }
    else { for (int r = gw; r < NROWS; r += ngw) ln_row(hf + (size_t)r * D, g, b, hf + (size_t)r * D, hb + (size_t)r * D, lane); }
}

constexpr int RUN = 8, NRUN = NROWS / RUN;
__device__ __forceinline__ void p2_phase(const Params& P, int l, size_t gtid, size_t gthreads) {
    const bf16_t* p = (const bf16_t*)(P.ws + WS_P); bf16_t* co = (bf16_t*)(P.ws + WS_CO); bf16_t* al = (bf16_t*)(P.ws + WS_AL);
    const float* cw = P.conv_w + (size_t)l * 3 * DA; const float* mu = P.mu + (size_t)l * 8384;
    const size_t tot = (size_t)NRUN * 160;
    for (size_t it = gtid; it < tot; it += gthreads) {
        const int run = (int)(it / 160), ch = (int)(it % 160); const int row0 = run * RUN;
        const int r1 = prev_row(row0), r2 = r1 >= 0 ? prev_row(r1) : -1;
        if (ch < 128) {
            const int c0 = ch * 8;
            float w0[8], w1[8], w2[8], u1[8], u2[8], xa[8], xb[8];
#pragma unroll
            for (int e = 0; e < 8; ++e) { w0[e] = cw[c0 + e]; w1[e] = cw[DA + c0 + e]; w2[e] = cw[2 * DA + c0 + e]; u1[e] = 0.f; u2[e] = 0.f; }
            if (r1 >= 0) { const bf16_t* q = p + (size_t)r1 * NP; unpack8(*(const u32x4*)(q + PC_XIN + c0), xa); unpack8(*(const u32x4*)(q + PC_CG + c0), xb);
#pragma unroll
                for (int e = 0; e < 8; ++e) u1[e] = xa[e] * xb[e]; }
            if (r2 >= 0) { const bf16_t* q = p + (size_t)r2 * NP; unpack8(*(const u32x4*)(q + PC_XIN + c0), xa); unpack8(*(const u32x4*)(q + PC_CG + c0), xb);
#pragma unroll
                for (int e = 0; e < 8; ++e) u2[e] = xa[e] * xb[e]; }
            u32x4 Lx[RUN], Lc[RUN], Lb[RUN], Lz[RUN];
#pragma unroll
            for (int rr = 0; rr < RUN; ++rr) { const bf16_t* pr = p + (size_t)(row0 + rr) * NP + c0; Lx[rr] = *(const u32x4*)(pr + PC_XIN); Lc[rr] = *(const u32x4*)(pr + PC_CG); Lb[rr] = *(const u32x4*)(pr + PC_BG); Lz[rr] = *(const u32x4*)(pr + PC_ZA); }
#pragma unroll
            for (int rr = 0; rr < RUN; ++rr) {
                float bg[8], z[8], o[8], u0[8]; unpack8(Lx[rr], xa); unpack8(Lc[rr], xb); unpack8(Lb[rr], bg); unpack8(Lz[rr], z);
#pragma unroll
                for (int e = 0; e < 8; ++e) { u0[e] = xa[e] * xb[e]; const float cv = w0[e] * u2[e] + w1[e] * u1[e] + w2[e] * u0[e]; o[e] = bg[e] * cv * siluf_(z[e]); u2[e] = u1[e]; u1[e] = u0[e]; }
                *(u32x4*)(co + (size_t)(row0 + rr) * DA + c0) = pack8(o);
            }
        } else {
            const int kc = (ch - 128) * 8;
            const bool isw = kc < LORA, isa = (kc >= 128 && kc < 128 + LORA);
            if (isw || isa) {
                const int pc = isw ? PC_WLO + kc : PC_ALO + (kc - 128); const int mi = isw ? 8192 + kc : 8288 + (kc - 128);
                float m[8], q[8], c[8], o[8];
#pragma unroll
                for (int e = 0; e < 8; ++e) { m[e] = mu[mi + e]; q[e] = 0.f; }
                if (r1 >= 0) unpack8(*(const u32x4*)(p + (size_t)r1 * NP + pc), q);
                u32x4 Lc[RUN];
#pragma unroll
                for (int rr = 0; rr < RUN; ++rr) Lc[rr] = *(const u32x4*)(p + (size_t)(row0 + rr) * NP + pc);
#pragma unroll
                for (int rr = 0; rr < RUN; ++rr) { unpack8(Lc[rr], c);
#pragma unroll
                    for (int e = 0; e < 8; ++e) { const float v = c[e] + m[e] * (q[e] - c[e]); o[e] = isw ? tanhf(v) : v; q[e] = c[e]; }
                    *(u32x4*)(al + (size_t)(row0 + rr) * 256 + kc) = pack8(o); }
            } else {
#pragma unroll
                for (int rr = 0; rr < RUN; ++rr) *(u32x4*)(al + (size_t)(row0 + rr) * 256 + kc) = (u32x4){0u, 0u, 0u, 0u};
            }
        }
    }
}

constexpr int TC = 32, NCH = 1 + SEQ / TC;
constexpr int REC = 1280;
constexpr int SC_OPND = 0, SC_V = TC * REC, SC_Y = SC_V + TC * 16 * 8, SC_BUF = SC_Y + TC * 16 * 4;
#define SCAN_BARRIER() do { asm volatile("s_waitcnt lgkmcnt(0)" ::: "memory"); __builtin_amdgcn_s_barrier(); asm volatile("" ::: "memory"); } while (0)
__device__ __forceinline__ void scan_phase(const Params& P, int l, LAS unsigned char* lds, const int tid) {
    const int wid = __builtin_amdgcn_readfirstlane(tid >> 6), lane = tid & 63;
    const bf16_t* p = (const bf16_t*)(P.ws + WS_P); const unsigned short* xb = (const unsigned short*)(P.ws + WS_HB); const unsigned short* ab = (const unsigned short*)(P.ws + WS_AB);
    bf16_t* sb = (bf16_t*)(P.ws + WS_SB); float* bon = (float*)(P.ws + WS_BON);
    for (int item = blockIdx.x; item < 256; item += gridDim.x) {
        const int xcd_ = item & 7, y_ = item >> 3, hh_ = xcd_ * 8 + (y_ >> 2);
        const int b = hh_ >> 5, h = hh_ & 31, q = y_ & 3;
        const int j = tid & 255, tt = j >> 3, cgp = j & 7, c0 = h * 64 + cgp * 8;
        const bool vown = (cgp >> 1) == q;
        u32x4 LAr0, LAr1, LAk0, LAk1, LAv0, LAv1, LAx, LAa, LBr0, LBr1, LBk0, LBk1, LBv0, LBv1, LBx, LBa;
        LAr0 = LAr1 = LAk0 = LAk1 = LAv0 = LAv1 = LAx = LAa = LBr0 = LBr1 = LBk0 = LBk1 = LBv0 = LBv1 = LBx = LBa = (u32x4){0u, 0u, 0u, 0u};
        const int rl = lane >> 4, kq = lane & 15, rowl = (wid & 3) * 4 + rl;
        f32x2 s01 = (f32x2){0.f, 0.f}, s23 = (f32x2){0.f, 0.f}; float yacc = 0.f;
#define CHUNK_ROW(c, t) ((c) == 0 ? NREAL + (t) : b * SEQ + ((c) - 1) * TC + (t))
#define ISSUE_LOADS(L, c) do { const bool valid_ = ((c) > 0) || (tt < NMETA); if (valid_) { const int row_ = CHUNK_ROW(c, tt); const int pr_ = prev_row(row_); \
            const bf16_t* a_ = p + (size_t)row_ * NP + c0; L##r0 = *(const u32x4*)(a_ + PC_R); L##k0 = *(const u32x4*)(a_ + PC_K); if (vown) L##v0 = *(const u32x4*)(a_ + PC_V); \
            L##x = *(const u32x4*)(xb + (size_t)row_ * DB + c0); L##a = *(const u32x4*)(ab + (size_t)row_ * DB + c0); \
            if (pr_ >= 0) { const bf16_t* a1_ = p + (size_t)pr_ * NP + c0; L##r1 = *(const u32x4*)(a1_ + PC_R); L##k1 = *(const u32x4*)(a1_ + PC_K); if (vown) L##v1 = *(const u32x4*)(a1_ + PC_V); } \
            else { L##r1 = L##k1 = L##v1 = (u32x4){0u, 0u, 0u, 0u}; } } } while (0)
        if (wid >= 4) {
            if (j < 96) {
                const float* mu = P.mu + (size_t)l * 8384; const int arr = j >> 4, c4 = h * 64 + (j & 15) * 4;
                const float* src = arr == 0 ? mu + c4 : arr == 1 ? mu + 2048 + c4 : arr == 2 ? mu + 4096 + c4 : arr == 3 ? P.kks + (size_t)l * DB + c4 : arr == 4 ? P.kas + (size_t)l * DB + c4 : P.rk + (size_t)l * DB + c4;
                ((LAS f32x4*)(lds + 2 * SC_BUF))[j] = *(const f32x4*)src;
            }
            ISSUE_LOADS(LA, 0); ISSUE_LOADS(LB, 1);
        } else {
            __builtin_amdgcn_s_setprio(2);
        }
        __syncthreads();
        float mur[8], muk[8], kks[8], kas[8], rks[8], muv[8];
        { LAS const f32x4* cst_ = (LAS const f32x4*)(lds + 2 * SC_BUF) + cgp * 2;
#pragma unroll
          for (int e = 0; e < 4; ++e) { muv[e] = cst_[32][e]; muv[4 + e] = cst_[33][e]; mur[e] = cst_[0][e]; mur[4 + e] = cst_[1][e]; muk[e] = cst_[16][e]; muk[4 + e] = cst_[17][e]; kks[e] = cst_[48][e]; kks[4 + e] = cst_[49][e];
              kas[e] = cst_[64][e]; kas[4 + e] = cst_[65][e]; rks[e] = cst_[80][e]; rks[4 + e] = cst_[81][e]; } }
#define SCAN_ITER(L, i) do { \
            if (wid >= 4) { \
                if ((i) >= 2 && (i) - 2 < NCH) {     \
                    const int c = (i) - 2; const bool valid = (c > 0) ? true : (tt < NMETA && b == 0); \
                    if (valid) { const LAS f32x2* yb = (const LAS f32x2*)(lds + ((i) & 1) * SC_BUF + SC_Y + tt * 64) + cgp; const f32x2 y = *yb; \
                        const f32x4 vc_ = *((const LAS f32x4*)(lds + ((i) & 1) * SC_BUF + SC_V + tt * 128) + cgp); \
                        *(unsigned*)(sb + (size_t)CHUNK_ROW(c, tt) * DB + h * 64 + q * 16 + 2 * cgp) = cvt_pk_bf16(y.x + vc_.y, y.y + vc_.w); } \
                } \
                if ((i) < NCH) { \
                    LAS unsigned char* buf = lds + ((i) & 1) * SC_BUF; \
                    const bool valid = ((i) > 0) || (tt < NMETA); \
                    float r0[8], r1[8], k0[8], k1[8], xx[8], aa[8]; \
                    unpack8(L##r0, r0); unpack8(L##r1, r1); unpack8(L##k0, k0); unpack8(L##k1, k1); unpack8h(L##x, xx); unpack8h(L##a, aa); \
                    float rr[8], kp[8], kkv[8], dec[8]; float ss = 0.f; \
                    _Pragma("unroll") for (int e = 0; e < 8; ++e) { rr[e] = r0[e] + mur[e] * (r1[e] - r0[e]); kp[e] = k0[e] + muk[e] * (k1[e] - k0[e]); dec[e] = __expf(-xx[e]); \
                        kkv[e] = kp[e] * kks[e]; ss += kkv[e] * kkv[e]; } \
                    ss = allred8(ss); \
                    const float inv = __builtin_amdgcn_rsqf(fmaxf(ss, 1e-24f)); \
                    float kk[8], kka[8], kt[8], wr[8]; float bs = 0.f, c1 = 0.f, c2 = 0.f; \
                    _Pragma("unroll") for (int e = 0; e < 8; ++e) { kk[e] = kkv[e] * inv; kka[e] = kk[e] * aa[e]; kt[e] = kp[e] * (1.0f + (aa[e] - 1.0f) * kas[e]); bs += rr[e] * kt[e] * rks[e]; \
                        wr[e] = dec[e] * rr[e]; c1 += kka[e] * rr[e]; c2 += kt[e] * rr[e]; } \
                    bs = allred8(bs); c1 = allred8(c1); c2 = allred8(c2); \
                    if (valid) { \
                        LAS f32x4* o = (LAS f32x4*)(buf + SC_OPND + tt * REC) + cgp * 2; \
                        float rp[8]; _Pragma("unroll") for (int e = 0; e < 8; ++e) rp[e] = wr[e] - c1 * kk[e]; \
                        o[0] = (f32x4){kk[0], rp[0], kk[1], rp[1]}; o[1] = (f32x4){kk[4], rp[4], kk[5], rp[5]}; \
                        o[16] = (f32x4){kk[2], rp[2], kk[3], rp[3]}; o[17] = (f32x4){kk[6], rp[6], kk[7], rp[7]}; \
                        o[32] = (f32x4){dec[0], dec[1], dec[2], dec[3]}; o[33] = (f32x4){dec[4], dec[5], dec[6], dec[7]}; \
                        o[48] = (f32x4){kka[0], kka[1], kka[2], kka[3]}; o[49] = (f32x4){kka[4], kka[5], kka[6], kka[7]}; \
                        o[64] = (f32x4){kt[0], kt[1], kt[2], kt[3]}; o[65] = (f32x4){kt[4], kt[5], kt[6], kt[7]}; \
                        if (vown) { float v0[8], v1[8]; unpack8(L##v0, v0); unpack8(L##v1, v1); \
                            LAS f32x4* vo = (LAS f32x4*)(buf + SC_V + tt * 128) + (cgp & 1) * 4; \
                            float vv[8]; \
                            _Pragma("unroll") for (int e = 0; e < 8; ++e) vv[e] = v0[e] + muv[e] * (v1[e] - v0[e]); \
                            vo[0] = (f32x4){vv[0], vv[0] * c2, vv[1], vv[1] * c2}; vo[1] = (f32x4){vv[2], vv[2] * c2, vv[3], vv[3] * c2}; \
                            vo[2] = (f32x4){vv[4], vv[4] * c2, vv[5], vv[5] * c2}; vo[3] = (f32x4){vv[6], vv[6] * c2, vv[7], vv[7] * c2}; } \
                        if (q == 0 && cgp == 0 && ((i) > 0 || b == 0)) bon[(size_t)CHUNK_ROW(i, tt) * 32 + h] = bs; \
                    } \
                } \
                if ((i) + 2 < NCH) ISSUE_LOADS(L, (i) + 2); \
            } else { \
                if ((i) >= 1 && (i) <= NCH) { \
                    const int c = (i) - 1; const int ntok = c == 0 ? NMETA : TC; \
                    LAS const unsigned char* buf = lds + (c & 1) * SC_BUF; \
                    LAS float* ybuf = (LAS float*)(lds + (c & 1) * SC_BUF + SC_Y) + (15 - kq) * 16 + rowl; \
                    f32x4 Akra, Akrb, Aw, Aka, Ak, Bkra, Bkrb, Bw, Bka, Bk; f32x2 Av, Bv; \
                    LAS const unsigned char* ob = buf + SC_OPND + kq * 16; LAS const unsigned char* vb = buf + SC_V + rowl * 8; \
                    LOADOPS(A, 0); \
                    _Pragma("unroll 1") for (int g = 0; g < ntok; g += 16) { \
                        asm volatile("" : "+v"(ob), "+v"(vb));     \
                        _Pragma("unroll") for (int u = 0; u < 8; ++u) { LOADOPS(B, 2 * u + 1); STEP(A); LOADOPS(A, 2 * u + 2); STEP(B); } \
                        ob += 16 * REC; vb += 16 * 128; \
                        ybuf[g * 16] = yacc; } \
                } \
            } \
            SCAN_BARRIER(); } while (0)
#define LOADOPS(S, t) do { S##kra = *(LAS const f32x4*)(ob + (t) * REC); S##krb = *(LAS const f32x4*)(ob + (t) * REC + 256); S##w = *(LAS const f32x4*)(ob + (t) * REC + 512); \
                        S##ka = *(LAS const f32x4*)(ob + (t) * REC + 768); S##k = *(LAS const f32x4*)(ob + (t) * REC + 1024); S##v = *(LAS const f32x2*)(vb + (t) * 128); } while (0)
#define LO2(v) __builtin_shufflevector(v, v, 0, 1)
#define HI2(v) __builtin_shufflevector(v, v, 2, 3)
#define STEP(S) do { \
                        f32x2 P_ = (f32x2){s01.x, s01.x} * LO2(S##kra); \
                        P_ = (f32x2){s01.y, s01.y} * HI2(S##kra) + P_; \
                        P_ = (f32x2){s23.x, s23.x} * LO2(S##krb) + P_; \
                        P_ = (f32x2){s23.y, s23.y} * HI2(S##krb) + P_; \
                        float sa_ = P_.x, yp_ = P_.y; \
                        f32x2 m01_ = s01 * LO2(S##w), m23_ = s23 * HI2(S##w); \
                        sa_ += dpp_mov<0xB1>(sa_); yp_ += dpp_mov<0xB1>(yp_); \
                        m01_ = (f32x2){S##v.x, S##v.x} * LO2(S##k) + m01_; \
                        sa_ += dpp_mov<0x4E>(sa_); yp_ += dpp_mov<0x4E>(yp_); \
                        m23_ = (f32x2){S##v.x, S##v.x} * HI2(S##k) + m23_; \
                        sa_ += dpp_mov<0x141>(sa_); yp_ += dpp_mov<0x141>(yp_); sa_ += dpp_mov<0x128>(sa_); yp_ += dpp_mov<0x128>(yp_); \
                        const f32x2 sa2_ = (f32x2){sa_, sa_}; \
                        s01 = m01_ - sa2_ * LO2(S##ka); s23 = m23_ - sa2_ * HI2(S##ka); \
                        yacc = __builtin_bit_cast(float, __builtin_amdgcn_update_dpp(__builtin_bit_cast(int, yp_), __builtin_bit_cast(int, yacc), 0x111, 0xf, 0xf, false)); } while (0)
#pragma unroll 1
        for (int i = 0; i < NCH + 2; i += 2) { SCAN_ITER(LA, i); SCAN_ITER(LB, i + 1); }
        if (wid < 4) __builtin_amdgcn_s_setprio(0);
        __syncthreads();
    }
}

__device__ __forceinline__ void p3b_phase(const Params& P, int l, size_t gtid, size_t gthreads) {
    const bf16_t* p = (const bf16_t*)(P.ws + WS_P); bf16_t* sb = (bf16_t*)(P.ws + WS_SB); const float* bon = (const float*)(P.ws + WS_BON);
    const float* mu = P.mu + (size_t)l * 8384; const float* gg = P.gn_g + (size_t)l * DB; const float* gb = P.gn_b + (size_t)l * DB;
    const size_t tot = (size_t)NRUN * 256;
    for (size_t it = gtid; it < tot; it += gthreads) {
        const int run = (int)(it >> 8), h = (int)((it >> 3) & 31), c0 = h * 64 + (int)(it & 7) * 8; const int row0 = run * RUN; const int r1 = prev_row(row0);
        float mv[8], mz[8], g8[8], b8[8], v1[8], z1[8];
#pragma unroll
        for (int e = 0; e < 8; ++e) { mv[e] = mu[4096 + c0 + e]; mz[e] = mu[6144 + c0 + e]; g8[e] = gg[c0 + e]; b8[e] = gb[c0 + e]; v1[e] = 0.f; z1[e] = 0.f; }
        if (r1 >= 0) { unpack8(*(const u32x4*)(p + (size_t)r1 * NP + PC_V + c0), v1); unpack8(*(const u32x4*)(p + (size_t)r1 * NP + PC_Z + c0), z1); }
        u32x4 Ly[RUN], Lv[RUN], Lz[RUN]; float Lb[RUN];
#pragma unroll
        for (int rr = 0; rr < RUN; ++rr) { const size_t row = (size_t)(row0 + rr); Ly[rr] = *(const u32x4*)(sb + row * DB + c0); Lv[rr] = *(const u32x4*)(p + row * NP + PC_V + c0); Lz[rr] = *(const u32x4*)(p + row * NP + PC_Z + c0); Lb[rr] = bon[row * 32 + h]; }
#pragma unroll
        for (int rr = 0; rr < RUN; ++rr) {
            float y[8], v0[8], z0[8], o[8]; unpack8(Ly[rr], y); unpack8(Lv[rr], v0); unpack8(Lz[rr], z0);
            float s1 = 0.f;
#pragma unroll
            for (int e = 0; e < 8; ++e) s1 += y[e];
            const float mean = allred8(s1) * (1.f / 64.f); float s2 = 0.f;
#pragma unroll
            for (int e = 0; e < 8; ++e) { y[e] -= mean; s2 += y[e] * y[e]; }
            const float rstd = __builtin_amdgcn_rsqf(allred8(s2) * (1.f / 64.f) + GN_EPS); const float bs = Lb[rr];
#pragma unroll
            for (int e = 0; e < 8; ++e) { const float vp = v0[e] + mv[e] * (v1[e] - v0[e]); const float zp = z0[e] + mz[e] * (z1[e] - z0[e]);
                o[e] = (y[e] * rstd * g8[e] + b8[e] + bs * vp) * siluf_(zp); v1[e] = v0[e]; z1[e] = z0[e]; }
            *(u32x4*)(sb + (size_t)(row0 + rr) * DB + c0) = pack8(o);
        }
    }
}

constexpr size_t WS_DBG = WS_END;
__device__ __forceinline__ void dbg_fail(const Params& P, unsigned bit) { atomicOr((unsigned*)(P.ws + WS_DBG), bit); }
__device__ __forceinline__ float bf2f(bf16_t v) { return __uint_as_float((unsigned)v << 16); }
__device__ __forceinline__ float h2f(unsigned short v) { return (float)__builtin_bit_cast(_Float16, v); }
__device__ __forceinline__ void chk_gemm1(const Params& P, int gw, int ngw, int lane) {
    const bf16_t* hb = (const bf16_t*)(P.ws + WS_HB); const bf16_t* wt = (const bf16_t*)(P.ws + WS_WIN); const bf16_t* p = (const bf16_t*)(P.ws + WS_P);
    for (int i = gw; i < 4096; i += ngw) { const int row = (int)(((long)i * 977) % NROWS), col = (int)(((long)i * 613) % NP);
        float s = 0.f; for (int k = lane; k < D; k += 64) s += bf2f(hb[(size_t)row * D + k]) * bf2f(wt[(size_t)col * D + k]);
        s = wave_sum(s); const float got = bf2f(p[(size_t)row * NP + col]);
        if (lane == 0 && !(fabsf(got - s) <= 0.03f + 0.02f * fabsf(s))) dbg_fail(P, 1u); }
}
__device__ __forceinline__ void chk_lora(const Params& P, int l, int gw, int ngw, int lane) {
    const bf16_t* al = (const bf16_t*)(P.ws + WS_AL); const bf16_t* wl = (const bf16_t*)(P.ws + WS_WL) + (size_t)l * 4096 * 256;
    const unsigned short* xb = (const unsigned short*)(P.ws + WS_HB); const unsigned short* ab = (const unsigned short*)(P.ws + WS_AB);
    for (int i = gw; i < 4096; i += ngw) { const int row = (int)(((long)i * 977) % NROWS), c = (int)(((long)i * 613) % DB);
        float s1 = 0.f, s2 = 0.f; for (int k = lane; k < 256; k += 64) { const float av = bf2f(al[(size_t)row * 256 + k]); s1 += av * bf2f(wl[(size_t)c * 256 + k]); s2 += av * bf2f(wl[(size_t)(2048 + c) * 256 + k]); }
        s1 = wave_sum(s1); s2 = wave_sum(s2);
        const float xr = 0.60653065971f / (1.f + expf(-(P.w0[(size_t)l * DB + c] + s1))), ar = 1.f / (1.f + expf(-(P.a0[(size_t)l * DB + c] + s2)));
        const float xg = h2f(xb[(size_t)row * DB + c]), ag = h2f(ab[(size_t)row * DB + c]);
        if (lane == 0 && !(fabsf(xg - xr) <= 1e-4f + 0.01f * fabsf(xr))) dbg_fail(P, 2u);
        if (lane == 0 && !(fabsf(ag - ar) <= 1e-3f + 0.01f * fabsf(ar))) dbg_fail(P, 4u); }
}
__device__ __forceinline__ void chk_scan(const Params& P, int l, LAS unsigned char* lds, int gw, int wid, int lane) {
    if (gw >= 8) return;
    const int b = gw & 1, h = (gw * 5 + 3) & 31;
    LAS float* S = (LAS float*)(lds + wid * 16384); LAS float* op = S + 64 * 49;
    const bf16_t* p = (const bf16_t*)(P.ws + WS_P); const unsigned short* xb = (const unsigned short*)(P.ws + WS_HB); const unsigned short* ab = (const unsigned short*)(P.ws + WS_AB);
    const bf16_t* sb = (const bf16_t*)(P.ws + WS_SB); const float* bon = (const float*)(P.ws + WS_BON);
    const float* mu = P.mu + (size_t)l * 8384; const int c = h * 64 + lane;
    (void)S; (void)op;
    LAS float* st = S + lane * 64;
    for (int k = 0; k < 64; ++k) st[(k + lane) & 63] = 0.f;
    const float mur = mu[c], muk = mu[2048 + c], muv = mu[4096 + c], kks = P.kks[(size_t)l * DB + c], kas = P.kas[(size_t)l * DB + c], rks = P.rk[(size_t)l * DB + c];
    for (int tau = 0; tau < 16 + 40; ++tau) {
        const int row = tau < 16 ? NREAL + tau : b * SEQ + (tau - 16); const int pr = prev_row(row);
        const float r0 = bf2f(p[(size_t)row * NP + PC_R + c]), k0 = bf2f(p[(size_t)row * NP + PC_K + c]), v0 = bf2f(p[(size_t)row * NP + PC_V + c]);
        const float r1 = pr >= 0 ? bf2f(p[(size_t)pr * NP + PC_R + c]) : 0.f, k1 = pr >= 0 ? bf2f(p[(size_t)pr * NP + PC_K + c]) : 0.f, v1 = pr >= 0 ? bf2f(p[(size_t)pr * NP + PC_V + c]) : 0.f;
        const float rr = r0 + mur * (r1 - r0), kp = k0 + muk * (k1 - k0), vp = v0 + muv * (v1 - v0);
        const float x = h2f(xb[(size_t)row * DB + c]), a = h2f(ab[(size_t)row * DB + c]);
        const float w = expf(-x); const float kkv = kp * kks; const float nrm = sqrtf(wave_sum(kkv * kkv)); const float kk = kkv / fmaxf(nrm, 1e-12f);
        const float kka = kk * a, kt = kp * (1.f + (a - 1.f) * kas);
        const float bs = wave_sum(rr * kt * rks);
        float sa = 0.f;
#pragma unroll 1
        for (int k = 0; k < 64; ++k) sa += st[(k + lane) & 63] * __shfl(kk, k);
        float y = 0.f;
#pragma unroll 1
        for (int k = 0; k < 64; ++k) { const float nv = st[(k + lane) & 63] * __shfl(w, k) - sa * __shfl(kka, k) + vp * __shfl(kt, k); st[(k + lane) & 63] = nv; y += nv * __shfl(rr, k); }
        if (tau >= 16 || b == 0) {
            const float yg = bf2f(sb[(size_t)row * DB + c]);
            if (!(fabsf(yg - y) <= 0.02f + 0.02f * fabsf(y))) dbg_fail(P, 8u);
            if (lane == 0 && !(fabsf(bon[(size_t)row * 32 + h] - bs) <= 1e-3f + 1e-3f * fabsf(bs))) dbg_fail(P, 16u);
        }
    }
}
__device__ __forceinline__ void chk_merged(const Params& P, int l, int gw, int ngw, int lane) {
    const bf16_t* co = (const bf16_t*)(P.ws + WS_CO); const bf16_t* sb = (const bf16_t*)(P.ws + WS_SB); const bf16_t* p = (const bf16_t*)(P.ws + WS_P); const bf16_t* mg = (const bf16_t*)(P.ws + WS_HB);
    const bf16_t* wa = (const bf16_t*)(P.ws + WS_WA) + (size_t)l * D * DA; const bf16_t* wb = (const bf16_t*)(P.ws + WS_WB) + (size_t)l * D * DB;
    for (int i = gw; i < 4096; i += ngw) { const int row = (int)(((long)i * 977) % NROWS), c = (int)(((long)i * 613) % D);
        float s1 = 0.f, s2 = 0.f; for (int k = lane; k < DA; k += 64) s1 += bf2f(co[(size_t)row * DA + k]) * bf2f(wa[(size_t)c * DA + k]);
        for (int k = lane; k < DB; k += 64) s2 += bf2f(sb[(size_t)row * DB + k]) * bf2f(wb[(size_t)c * DB + k]);
        s1 = wave_sum(s1); s2 = wave_sum(s2);
        const float ga = 1.f / (1.f + expf(-bf2f(p[(size_t)row * NP + PC_GA + c]))), gb = 1.f / (1.f + expf(-bf2f(p[(size_t)row * NP + PC_GB + c])));
        const float m = ga * s1 + gb * s2, got = bf2f(mg[(size_t)row * D + c]);
        if (lane == 0 && !(fabsf(got - m) <= 0.01f + 0.03f * fabsf(m))) dbg_fail(P, 32u); }
}
#define LAUNDER(v) asm volatile("" : "+v"(v))
#if defined(__HIP_DEVICE_COMPILE__)
#define GETPARAMS const Params P = *Pp
#else
#define GETPARAMS const Params P = Pformal
#endif
__global__ void __launch_bounds__(512, 2) fwd_megakernel(Params Pformal) {
    extern __shared__ __attribute__((aligned(16))) unsigned char shm[];
    LAS unsigned char* lds = (LAS unsigned char*)shm;
    cg::grid_group grid = cg::this_grid();
    const int G = gridDim.x;
#define TIDS() const __attribute__((address_space(4))) Params* Pp = (const __attribute__((address_space(4))) Params*)__builtin_amdgcn_kernarg_segment_ptr(); asm volatile("" : "+s"(Pp)); GETPARAMS; \
    bf16_t* hb = (bf16_t*)(P.ws + WS_HB); bf16_t* pbuf = (bf16_t*)(P.ws + WS_P); (void)hb; (void)pbuf; \
    int tid = threadIdx.x; LAUNDER(tid); const int wid = __builtin_amdgcn_readfirstlane(tid >> 6), lane = tid & 63; const int gw = blockIdx.x * 8 + wid, ngw = G * 8; (void)lane; (void)gw; (void)ngw
    { TIDS();
#ifdef DBG_CHECKS
      if (blockIdx.x == 0 && tid == 0) *(unsigned*)(P.ws + WS_DBG) = 0u;
#endif
      convert_small(P, lds, gw, ngw, wid, lane); }
    { TIDS(); convert_win(P, 0, lds, gw, ngw, wid, lane); }
    { TIDS(); embed_phase(P, gw, ngw, lane); }
    grid.sync();
    for (int l = 0; l < DEPTH; ++l) {
        {
            TIDS();
            pg8::Gemm g{hb, (const bf16_t*)(P.ws + WS_WIN), MPAD, NP, D}; pg8::StaticOrder S; S.init(MPAD, NP, G, blockIdx.x);
            EpiP E{pbuf}; pg8::gemm_run(lds, g, S, E, tid);
        }
        grid.sync();
#ifdef DBG_CHECKS
        if (l == 0) { TIDS(); chk_gemm1(P, gw, ngw, lane); }
#endif
        { TIDS(); p2_phase(P, l, (size_t)blockIdx.x * 512 + tid, (size_t)G * 512); }
        grid.sync();
        {
            TIDS();
            pg8::Gemm g{(const bf16_t*)(P.ws + WS_AL), (const bf16_t*)(P.ws + WS_WL) + (size_t)l * 4096 * 256, MPAD, 4096, 256}; pg8::StaticOrder S; S.init(MPAD, 4096, G, blockIdx.x);
            EpiLora E{(unsigned short*)(P.ws + WS_HB), (unsigned short*)(P.ws + WS_AB), P.w0 + (size_t)l * DB, P.a0 + (size_t)l * DB}; pg8::gemm_run(lds, g, S, E, tid);
        }
        grid.sync();
#ifdef DBG_CHECKS
        if (l == 0) { TIDS(); chk_lora(P, l, gw, ngw, lane); }
#endif
        { TIDS(); scan_phase(P, l, lds, tid); }
        grid.sync();
#ifdef DBG_CHECKS
        if (l == 0) { TIDS(); chk_scan(P, l, lds, gw, wid, lane); grid.sync(); }
#endif
        { TIDS(); p3b_phase(P, l, (size_t)blockIdx.x * 512 + tid, (size_t)G * 512); }
        if (l + 1 < DEPTH) { TIDS(); convert_win(P, l + 1, lds, gw, ngw, wid, lane); }
        grid.sync();
        {
            TIDS();
            pg8::StaticOrder S; S.init(NREAL, D, G, blockIdx.x);
            pg8::Gemm ga{(const bf16_t*)(P.ws + WS_CO), (const bf16_t*)(P.ws + WS_WA) + (size_t)l * D * DA, NREAL, D, DA};
            EpiY<false> Ea{hb, pbuf, PC_GA}; pg8::gemm_run(lds, ga, S, Ea, tid);
        }
        {
            TIDS();
            pg8::StaticOrder S; S.init(NREAL, D, G, blockIdx.x);
            pg8::Gemm gb{(const bf16_t*)(P.ws + WS_SB), (const bf16_t*)(P.ws + WS_WB) + (size_t)l * D * DB, NREAL, D, DB};
            EpiY<true> Eb{hb, pbuf, PC_GB}; pg8::gemm_run(lds, gb, S, Eb, tid);
        }
        { TIDS(); meta_p4(P, l, lds, wid, lane); }
        grid.sync();
#ifdef DBG_CHECKS
        if (l == 0) { TIDS(); chk_merged(P, l, gw, ngw, lane); }
#endif
        {
            TIDS();
            pg8::StaticOrder S; S.init(NREAL, D, G, blockIdx.x);
            pg8::Gemm g{hb, (const bf16_t*)(P.ws + WS_WO) + (size_t)l * D * D, NREAL, D, D};
            EpiOut E{(float*)(P.ws + WS_HF)}; pg8::gemm_run(lds, g, S, E, tid);
        }
        { TIDS(); meta_p5(P, l, lds, wid, lane); }
        grid.sync();
        { TIDS(); ln_phase(P, l, gw, ngw, lane); }
        if (l + 1 < DEPTH) grid.sync();
    }
#ifdef DBG_CHECKS
    grid.sync();
    { TIDS(); if (blockIdx.x == 0 && tid == 0) { const unsigned f = *(volatile unsigned*)(P.ws + WS_DBG); if (f) P.out[0] = 100.f * (float)(10 + f); } }
#endif
}

constexpr int LDS_BYTES = 131072;
extern "C" void kernel_launch(void* const* d_in, const int* in_sizes, int n_in, void* d_out, int out_size, void* d_ws, size_t ws_size, hipStream_t stream) {
    static int grid_blocks = 0;
    if (grid_blocks == 0) {
        if (n_in != 21 || ws_size < WS_END + 256) { fprintf(stderr, "kernel_launch: unexpected n_in %d / ws_size %zu (need %zu)\n", n_in, ws_size, (size_t)WS_END); grid_blocks = -1; return; }
        int dev = 0, cus = 0, per_cu = 0;
        hipGetDevice(&dev); hipDeviceGetAttribute(&cus, hipDeviceAttributeMultiprocessorCount, dev);
        if (hipFuncSetAttribute((const void*)fwd_megakernel, hipFuncAttributeMaxDynamicSharedMemorySize, LDS_BYTES) != hipSuccess) fprintf(stderr, "kernel_launch: hipFuncSetAttribute failed\n");
        if (hipOccupancyMaxActiveBlocksPerMultiprocessor(&per_cu, (const void*)fwd_megakernel, 512, LDS_BYTES) != hipSuccess || per_cu < 1) { fprintf(stderr, "kernel_launch: occupancy query gave %d\n", per_cu); per_cu = 1; }
        (void)hipGetLastError();
        grid_blocks = cus * per_cu;
        if (grid_blocks > 256) grid_blocks = 256;
    }
    if (grid_blocks < 0) return;
    Params p{};
    const float** pp = (const float**)&p;
    for (int i = 0; i < 21; ++i) pp[i] = (const float*)d_in[i];
    p.out = (float*)d_out; p.ws = (unsigned char*)d_ws;
    void* args[] = {&p};
    hipError_t e = hipLaunchCooperativeKernel((const void*)fwd_megakernel, dim3(grid_blocks), dim3(512), args, LDS_BYTES, stream);
    if (e != hipSuccess) fprintf(stderr, "cooperative launch failed: %s (grid %d)\n", hipGetErrorString(e), grid_blocks);
}
```

```cpp
#include <hip/hip_runtime.h>
#include <hip/hip_cooperative_groups.h>
#include <cstdio>
#include <cstdint>
namespace cg = cooperative_groups;

#define LAS __attribute__((address_space(3)))
typedef unsigned short bf16_t;
typedef short bf16x8 __attribute__((ext_vector_type(8)));
typedef float f32x4 __attribute__((ext_vector_type(4)));
typedef float f32x2 __attribute__((ext_vector_type(2)));
typedef unsigned u32x4 __attribute__((ext_vector_type(4)));
typedef unsigned u32x2 __attribute__((ext_vector_type(2)));
typedef _Float16 h16x2 __attribute__((ext_vector_type(2)));

constexpr int D = 2048, SEQ = 16384, NBATCH = 2, DEPTH = 4;
constexpr int NREAL = NBATCH * SEQ;
constexpr int NMETA = 16;
constexpr int NROWS = NREAL + NMETA;
constexpr int MPAD = 33024;
constexpr int NCOLS = 16576, NP = 16640;
constexpr int DA = 1024, DB = 2048, NHEAD = 32, LORA = 96;
constexpr int PC_XIN = 0, PC_BG = 1024, PC_CG = 2048, PC_ZA = 3072, PC_R = 4096, PC_K = 6144, PC_V = 8192, PC_Z = 10240,
              PC_GA = 12288, PC_GB = 14336, PC_WLO = 16384, PC_ALO = 16480;
constexpr float LN_EPS = 1e-5f, GN_EPS = 6.4e-4f;
constexpr float ALPHA = 1.6817928305074292f;

constexpr size_t al256(size_t x) { return (x + 255) & ~(size_t)255; }
constexpr size_t WS_WIN = 0;
constexpr size_t WS_WA = al256(WS_WIN + (size_t)NP * D * 2);
constexpr size_t WS_WB = al256(WS_WA + (size_t)DEPTH * D * DA * 2);
constexpr size_t WS_WO = al256(WS_WB + (size_t)DEPTH * D * DB * 2);
constexpr size_t WS_WL = al256(WS_WO + (size_t)DEPTH * D * D * 2);
constexpr size_t WS_HF = al256(WS_WL + (size_t)DEPTH * 4096 * 256 * 2);
constexpr size_t WS_HB = al256(WS_HF + (size_t)MPAD * D * 4);
constexpr size_t WS_P = al256(WS_HB + (size_t)MPAD * D * 2);
constexpr size_t WS_CO = al256(WS_P + (size_t)MPAD * NP * 2);
constexpr size_t WS_SB = al256(WS_CO + (size_t)MPAD * DA * 2);
constexpr size_t WS_AB = al256(WS_SB + (size_t)MPAD * DB * 2);
constexpr size_t WS_AL = al256(WS_AB + (size_t)MPAD * DB * 2);
constexpr size_t WS_BON = al256(WS_AL + (size_t)MPAD * 256 * 2);
constexpr size_t WS_END = al256(WS_BON + (size_t)MPAD * 32 * 4);

struct Params {
    const float *x, *meta, *emb_g, *emb_b, *w_in, *conv_w, *w_a, *mu, *w0, *w2, *a0, *a2, *kks, *kas, *rk, *gn_g, *gn_b, *w_b, *w_out, *ln_g, *ln_b;
    float* out; unsigned char* ws;
};

__device__ __forceinline__ unsigned cvt_pk_bf16(float lo, float hi) { unsigned r; asm volatile("v_cvt_pk_bf16_f32 %0, %1, %2" : "=v"(r) : "v"(lo), "v"(hi)); return r; }
__device__ __forceinline__ float bf_lo(unsigned w) { return __uint_as_float(w << 16); }
__device__ __forceinline__ float bf_hi(unsigned w) { return __uint_as_float(w & 0xffff0000u); }
__device__ __forceinline__ void unpack8(const u32x4 w, float (&f)[8]) {
    f[0] = bf_lo(w.x); f[1] = bf_hi(w.x); f[2] = bf_lo(w.y); f[3] = bf_hi(w.y); f[4] = bf_lo(w.z); f[5] = bf_hi(w.z); f[6] = bf_lo(w.w); f[7] = bf_hi(w.w);
}
__device__ __forceinline__ u32x4 pack8(const float (&f)[8]) {
    u32x4 w; w.x = cvt_pk_bf16(f[0], f[1]); w.y = cvt_pk_bf16(f[2], f[3]); w.z = cvt_pk_bf16(f[4], f[5]); w.w = cvt_pk_bf16(f[6], f[7]); return w;
}
__device__ __forceinline__ unsigned pack_h2(float a, float b) { h16x2 v; v.x = (_Float16)a; v.y = (_Float16)b; return __builtin_bit_cast(unsigned, v); }
__device__ __forceinline__ float h_lo(unsigned w) { return (float)__builtin_bit_cast(_Float16, (unsigned short)(w & 0xffffu)); }
__device__ __forceinline__ float h_hi(unsigned w) { return (float)__builtin_bit_cast(_Float16, (unsigned short)(w >> 16)); }
__device__ __forceinline__ void unpack8h(const u32x4 w, float (&f)[8]) {
    f[0] = h_lo(w.x); f[1] = h_hi(w.x); f[2] = h_lo(w.y); f[3] = h_hi(w.y); f[4] = h_lo(w.z); f[5] = h_hi(w.z); f[6] = h_lo(w.w); f[7] = h_hi(w.w);
}
__device__ __forceinline__ float sigmoidf_(float v) { return __builtin_amdgcn_rcpf(1.0f + __expf(-v)); }
__device__ __forceinline__ float siluf_(float v) { return v * sigmoidf_(v); }
template <int CTRL> __device__ __forceinline__ float dpp_mov(float x) {
    return __builtin_bit_cast(float, __builtin_amdgcn_mov_dpp(__builtin_bit_cast(int, x), CTRL, 0xf, 0xf, true));
}
__device__ __forceinline__ float allred8(float x) { x += dpp_mov<0xB1>(x); x += dpp_mov<0x4E>(x); x += dpp_mov<0x141>(x); return x; }
__device__ __forceinline__ float allred16(float x) { x = allred8(x); x += dpp_mov<0x128>(x); return x; }
__device__ __forceinline__ float wave_sum(float v) {
#pragma unroll
    for (int o = 1; o < 64; o <<= 1) v += __shfl_xor(v, o);
    return v;
}
__device__ __forceinline__ int prev_row(int r) { if (r >= NREAL) return r == NREAL ? -1 : r - 1; return (r & (SEQ - 1)) ? r - 1 : NROWS - 1; }

#ifndef GEMM_SP2
#define GEMM_SP2 true
#endif
#ifndef GEMM_ALIGN
#define GEMM_ALIGN true
#endif
namespace pg8 {
constexpr int BM = 256, BK = 64, HALF = 128, HTB = HALF * BK * 2, STAGE_BYTES = 8 * HTB, NXCD = 8, WGM = 4;
__host__ __device__ __forceinline__ int lds_byte(int r, int c) { const int st = (r >> 4) * 2 + (c >> 5), rr = r & 15, cc = c & 31, ob = rr * 64 + cc * 2; return st * 1024 + (ob ^ (((ob >> 9) & 1) << 5)); }
__host__ __device__ __forceinline__ void stage_rc(int b, int& R, int& C) { const int st = b / 1024, sb = b % 1024, swz = sb ^ (((sb >> 9) & 1) << 5); R = (st >> 1) * 16 + swz / 64; C = (st & 1) * 32 + (swz % 64) / 2; }
__host__ __device__ __forceinline__ int perm32(int rho) { const int n = rho >> 4, i = rho & 15; return 8 * (i >> 2) + 4 * n + (i & 3); }
struct Unit { int pm, pn; };
struct Gemm { const bf16_t* A; const bf16_t* Bt; int M, N, K; };
struct StaticOrder {
    int nM, nN, nwg, G, c;
    __device__ void init(int M, int N, int G_, int c_) { nM = M / BM; nN = N / BM; nwg = nM * nN; G = G_; c = c_; }
    __device__ bool next(int i, Unit& u) const {
        const long L = (long)i * G + c; if (L >= nwg) return false;
        int wgid = (int)L; { const int q = nwg / NXCD, r = nwg % NXCD, xcd = wgid % NXCD, off = wgid / NXCD; wgid = (xcd < r ? xcd * (q + 1) : r * (q + 1) + (xcd - r) * q) + off; }
        const int nig = WGM * nN, gid = wgid / nig, fm = gid * WGM, gsz = (nM - fm) < WGM ? (nM - fm) : WGM;
        u.pm = fm + ((wgid % nig) % gsz); u.pn = (wgid % nig) / gsz; return true;
    }
    __device__ __forceinline__ void a_ready(const Unit&) const {}
    __device__ __forceinline__ void done(const Unit&) const {}
};

template <class Epi, class Sched, bool ALIGN_EPI = false, bool SP2 = false>
__device__ __forceinline__ void gemm_phase(LAS unsigned char* lds, const Gemm g, const Sched& S, const Epi& E, const int tid) {
    const int wid = __builtin_amdgcn_readfirstlane(tid >> 6), lane = tid & 63, wr = wid >> 2, wc = wid & 3, fr = lane & 15, fq = lane >> 4;
    int K = g.K; asm volatile("" : "+s"(K)); const int nt = K / BK;
    unsigned voffA[2], voffB[2];
#pragma unroll
    for (int i = 0; i < 2; ++i) { int R, C; stage_rc(tid * 16 + i * 8192, R, C); const int Rb = Epi::PERM ? ((R & ~31) + perm32(R & 31)) : R;
        voffA[i] = (unsigned)(R * K + C) * 2u; voffB[i] = (unsigned)(Rb * K + C) * 2u; }
    const size_t kstep = (size_t)(BK * 2);
    const size_t hstep = (size_t)HALF * K * 2;
    const size_t tstep = 2 * hstep;
    const unsigned ldsw = (unsigned)wid * 1024u;
    const int aoff = lds_byte(wr * 64 + fr, fq * 8), boff = lds_byte(wc * 32 + fr, fq * 8);
#define PG8_SA(b, h) (((b) * 2 + (h)) * HTB)
#define PG8_SB(b, h) ((4 + (b) * 2 + (h)) * HTB)
#define PG8_STAGE(bufoff, gbase, voff) do { _Pragma("unroll") for (int _i = 0; _i < 2; ++_i) \
        __builtin_amdgcn_global_load_lds((const unsigned*)((const char*)(gbase) + (voff)[_i]), (LAS unsigned*)(lds + (bufoff) + ldsw + _i * 8192), 16, 0, 0); } while (0)
#define PG8_LDA(dst, b, h) do { _Pragma("unroll") for (int m = 0; m < 4; ++m) _Pragma("unroll") for (int k = 0; k < 2; ++k) dst[m][k] = *(const LAS bf16x8*)(lds + PG8_SA(b, h) + aoff + m * 2048 + k * 1024); } while (0)
#define PG8_LDB(dst, b, h) do { _Pragma("unroll") for (int n = 0; n < 2; ++n) _Pragma("unroll") for (int k = 0; k < 2; ++k) dst[n][k] = *(const LAS bf16x8*)(lds + PG8_SB(b, h) + boff + n * 2048 + k * 1024); } while (0)
#define PG8_MMA(ai, bj, At, Bt) do { __builtin_amdgcn_s_setprio(1); _Pragma("unroll") for (int m = 0; m < 4; ++m) _Pragma("unroll") for (int n = 0; n < 2; ++n) _Pragma("unroll") for (int k = 0; k < 2; ++k) \
        acc[ai][bj][m][n] = __builtin_amdgcn_mfma_f32_16x16x32_bf16(Bt[n][k], At[m][k], acc[ai][bj][m][n], 0, 0, 0); __builtin_amdgcn_s_setprio(0); } while (0)
#define PG8_WAIT_V(n) asm volatile("s_waitcnt vmcnt(" #n ")" ::: "memory")
#define PG8_WAIT_L(n) asm volatile("s_waitcnt lgkmcnt(" #n ")" ::: "memory")
#define PG8_BAR __builtin_amdgcn_s_barrier()
#define PG8_SCHED __builtin_amdgcn_sched_barrier(0)
    Unit cur, nxt; int ui = 0;
    if (!S.next(0, cur)) return;
    f32x4 acc[2][2][4][2];
#pragma unroll
    for (int a = 0; a < 2; ++a)
#pragma unroll
        for (int b = 0; b < 2; ++b)
#pragma unroll
            for (int m = 0; m < 4; ++m)
#pragma unroll
                for (int n = 0; n < 2; ++n) acc[a][b][m][n] = (f32x4){0.f, 0.f, 0.f, 0.f};
    bf16x8 At[4][2], B0[2][2], B1[2][2];
    const char* cA = (const char*)g.A + (size_t)cur.pm * tstep; const char* cB = (const char*)g.Bt + (size_t)cur.pn * tstep;
    S.a_ready(cur);
    if constexpr (SP2) {
        PG8_STAGE(PG8_SB(0, 0), cB, voffB); PG8_STAGE(PG8_SB(0, 1), cB + hstep, voffB); PG8_STAGE(PG8_SA(0, 0), cA, voffA); PG8_STAGE(PG8_SA(0, 1), cA + hstep, voffA);
        if (wr == 1) PG8_BAR;
        PG8_WAIT_V(2); PG8_BAR;
        PG8_STAGE(PG8_SB(1, 0), cB + kstep, voffB); PG8_STAGE(PG8_SA(1, 0), cA + kstep, voffA); PG8_STAGE(PG8_SB(1, 1), cB + hstep + kstep, voffB);
        PG8_WAIT_V(6); PG8_BAR;
    } else {
        PG8_STAGE(PG8_SB(0, 0), cB, voffB); PG8_STAGE(PG8_SA(0, 0), cA, voffA); PG8_STAGE(PG8_SB(0, 1), cB + hstep, voffB); PG8_STAGE(PG8_SA(0, 1), cA + hstep, voffA);
        if (wr == 1) PG8_BAR;
        PG8_WAIT_V(4); PG8_BAR;
        PG8_STAGE(PG8_SB(1, 0), cB + kstep, voffB); PG8_STAGE(PG8_SA(1, 0), cA + kstep, voffA); PG8_STAGE(PG8_SB(1, 1), cB + hstep + kstep, voffB);
        PG8_WAIT_V(6); PG8_BAR;
    }
    for (;;) {
        const bool has_next = S.next(ui + 1, nxt);
        const char* nA = has_next ? (const char*)g.A + (size_t)nxt.pm * tstep : cA; const char* nB = has_next ? (const char*)g.Bt + (size_t)nxt.pn * tstep : cB;
        for (int t = 0; t < nt; t += 2) {
            const bool last = (t == nt - 2);
            const char* a1 = cA + (size_t)(t + 1) * kstep;
            const char* a2 = last ? nA : cA + (size_t)(t + 2) * kstep; const char* b2 = last ? nB : cB + (size_t)(t + 2) * kstep;
            const char* a3 = a2 + kstep; const char* b3 = b2 + kstep;
            if (last && has_next) S.a_ready(nxt);
            if constexpr (SP2) {
            PG8_LDB(B0, 0, 0); PG8_LDB(B1, 0, 1); PG8_SCHED; PG8_LDA(At, 0, 0); PG8_STAGE(PG8_SA(1, 1), a1 + hstep, voffA);
            PG8_WAIT_V(8); PG8_WAIT_L(0); PG8_BAR; PG8_MMA(0, 0, At, B0); PG8_MMA(0, 1, At, B1); PG8_BAR; PG8_SCHED;
            PG8_LDA(At, 0, 1); PG8_STAGE(PG8_SB(0, 0), b2, voffB); PG8_STAGE(PG8_SB(0, 1), b2 + hstep, voffB); PG8_STAGE(PG8_SA(0, 0), a2, voffA);
            PG8_WAIT_V(8); PG8_WAIT_L(0); PG8_BAR; PG8_MMA(1, 0, At, B0); PG8_MMA(1, 1, At, B1); PG8_BAR; PG8_SCHED;
            PG8_LDB(B0, 1, 0); PG8_LDB(B1, 1, 1); PG8_SCHED; PG8_LDA(At, 1, 0); PG8_STAGE(PG8_SA(0, 1), a2 + hstep, voffA);
            PG8_WAIT_V(8); PG8_WAIT_L(0); PG8_BAR; PG8_MMA(0, 0, At, B0); PG8_MMA(0, 1, At, B1); PG8_BAR; PG8_SCHED;
            PG8_LDA(At, 1, 1); PG8_STAGE(PG8_SB(1, 0), b3, voffB); PG8_STAGE(PG8_SB(1, 1), b3 + hstep, voffB); PG8_STAGE(PG8_SA(1, 0), a3, voffA);
            PG8_WAIT_V(8); PG8_WAIT_L(0); PG8_BAR; PG8_MMA(1, 0, At, B0); PG8_MMA(1, 1, At, B1); PG8_BAR; PG8_SCHED;
            } else {
            PG8_LDB(B0, 0, 0); PG8_SCHED; PG8_LDA(At, 0, 0); PG8_STAGE(PG8_SA(1, 1), a1 + hstep, voffA);
            PG8_WAIT_L(8); PG8_BAR; PG8_WAIT_L(0); PG8_MMA(0, 0, At, B0); PG8_BAR; PG8_SCHED;
            PG8_LDB(B1, 0, 1); PG8_STAGE(PG8_SB(0, 0), b2, voffB);
            PG8_BAR; PG8_WAIT_L(0); PG8_MMA(0, 1, At, B1); PG8_BAR;
            PG8_LDA(At, 0, 1); PG8_STAGE(PG8_SA(0, 0), a2, voffA);
            PG8_BAR; PG8_WAIT_L(0); PG8_MMA(1, 0, At, B0); PG8_BAR; PG8_SCHED;
            PG8_STAGE(PG8_SB(0, 1), b2 + hstep, voffB);
            PG8_WAIT_V(6); PG8_BAR; PG8_MMA(1, 1, At, B1); PG8_BAR;
            PG8_LDB(B0, 1, 0); PG8_SCHED; PG8_LDA(At, 1, 0); PG8_STAGE(PG8_SA(0, 1), a2 + hstep, voffA);
            PG8_WAIT_L(8); PG8_BAR; PG8_WAIT_L(0); PG8_MMA(0, 0, At, B0); PG8_BAR; PG8_SCHED;
            PG8_LDB(B1, 1, 1); PG8_STAGE(PG8_SB(1, 0), b3, voffB);
            PG8_BAR; PG8_WAIT_L(0); PG8_MMA(0, 1, At, B1); PG8_BAR;
            PG8_LDA(At, 1, 1); PG8_STAGE(PG8_SA(1, 0), a3, voffA);
            PG8_BAR; PG8_WAIT_L(0); PG8_MMA(1, 0, At, B0); PG8_BAR; PG8_SCHED;
            PG8_STAGE(PG8_SB(1, 1), b3 + hstep, voffB);
            PG8_WAIT_V(6); PG8_BAR; PG8_MMA(1, 1, At, B1); PG8_BAR;
            }
        }
        if constexpr (ALIGN_EPI) { if (wr == 0) PG8_BAR; }
        E(acc, cur, wr, wc, fr, fq); S.done(cur);
        if (!has_next) break;
#pragma unroll
        for (int a = 0; a < 2; ++a)
#pragma unroll
            for (int b = 0; b < 2; ++b)
#pragma unroll
                for (int m = 0; m < 4; ++m)
#pragma unroll
                    for (int n = 0; n < 2; ++n) acc[a][b][m][n] = (f32x4){0.f, 0.f, 0.f, 0.f};
        cur = nxt; cA = nA; cB = nB; ++ui;
        if constexpr (ALIGN_EPI) { if (wr == 1) PG8_BAR; }
    }
    PG8_WAIT_V(0);
    if constexpr (!ALIGN_EPI) { if (wr == 0) PG8_BAR; }
    PG8_BAR;
#undef PG8_SA
#undef PG8_SB
#undef PG8_STAGE
#undef PG8_LDA
#undef PG8_LDB
#undef PG8_MMA
#undef PG8_WAIT_V
#undef PG8_WAIT_L
#undef PG8_BAR
#undef PG8_SCHED
}
template <class Epi>
__device__ __forceinline__ void gemm_run(LAS unsigned char* lds, const Gemm g, const StaticOrder& S, const Epi& E, const int tid) { gemm_phase<Epi, StaticOrder, GEMM_ALIGN, GEMM_SP2>(lds, g, S, E, tid); }
}

struct EpiP {
    static constexpr bool PERM = true;
    bf16_t* O;
    __device__ __forceinline__ void operator()(const f32x4 (&acc)[2][2][4][2], const pg8::Unit& u, int wr, int wc, int fr, int fq) const {
        const int row0 = u.pm * 256 + wr * 64 + fr, col0 = u.pn * 256 + wc * 32 + 8 * fq;
#pragma unroll
        for (int ai = 0; ai < 2; ++ai)
#pragma unroll
            for (int m = 0; m < 4; ++m) { bf16_t* rowp = O + (size_t)(row0 + ai * 128 + m * 16) * NP + col0;
#pragma unroll
                for (int bj = 0; bj < 2; ++bj) { const f32x4 v0 = acc[ai][bj][m][0], v1 = acc[ai][bj][m][1];
                    u32x4 w; w.x = cvt_pk_bf16(v0[0], v0[1]); w.y = cvt_pk_bf16(v0[2], v0[3]); w.z = cvt_pk_bf16(v1[0], v1[1]); w.w = cvt_pk_bf16(v1[2], v1[3]);
                    *(u32x4*)(rowp + bj * 128) = w; } }
    }
};
struct EpiLora {
    static constexpr bool PERM = true;
    unsigned short *X, *Ab; const float *w0, *a0;
    __device__ __forceinline__ void operator()(const f32x4 (&acc)[2][2][4][2], const pg8::Unit& u, int wr, int wc, int fr, int fq) const {
        const int row0 = u.pm * 256 + wr * 64 + fr; const int colt = u.pn * 256; const bool isA = colt >= 2048;
        unsigned short* base = isA ? Ab : X; const float* bias = isA ? a0 : w0; const float scale = isA ? 1.0f : 0.60653065971f;
        const int cc = (colt & 2047) + wc * 32 + 8 * fq;
        f32x4 bv[2][2];
#pragma unroll
        for (int bj = 0; bj < 2; ++bj) { bv[bj][0] = *(const f32x4*)(bias + cc + bj * 128); bv[bj][1] = *(const f32x4*)(bias + cc + bj * 128 + 4); }
#pragma unroll
        for (int ai = 0; ai < 2; ++ai)
#pragma unroll
            for (int m = 0; m < 4; ++m) { unsigned short* rowp = base + (size_t)(row0 + ai * 128 + m * 16) * DB + cc;
#pragma unroll
                for (int bj = 0; bj < 2; ++bj) { const f32x4 v0 = acc[ai][bj][m][0] + bv[bj][0], v1 = acc[ai][bj][m][1] + bv[bj][1];
                    u32x4 w; w.x = pack_h2(scale * sigmoidf_(v0[0]), scale * sigmoidf_(v0[1])); w.y = pack_h2(scale * sigmoidf_(v0[2]), scale * sigmoidf_(v0[3]));
                    w.z = pack_h2(scale * sigmoidf_(v1[0]), scale * sigmoidf_(v1[1])); w.w = pack_h2(scale * sigmoidf_(v1[2]), scale * sigmoidf_(v1[3]));
                    *(u32x4*)(rowp + bj * 128) = w; } }
    }
};
template <bool ACCUM> struct EpiY {
    static constexpr bool PERM = true;
    bf16_t* Mg; const bf16_t* P; int gcol;
    __device__ __forceinline__ void operator()(const f32x4 (&acc)[2][2][4][2], const pg8::Unit& u, int wr, int wc, int fr, int fq) const {
        const int row0 = u.pm * 256 + wr * 64 + fr, col0 = u.pn * 256 + wc * 32 + 8 * fq;
#pragma unroll
        for (int ai = 0; ai < 2; ++ai)
#pragma unroll
            for (int m = 0; m < 4; ++m) { const int row = row0 + ai * 128 + m * 16;
#pragma unroll
                for (int bj = 0; bj < 2; ++bj) { const int col = col0 + bj * 128;
                    const u32x4 gw = *(const u32x4*)(P + (size_t)row * NP + gcol + col);
                    float g[8], o[8]; unpack8(gw, g);
                    const f32x4 v0 = acc[ai][bj][m][0], v1 = acc[ai][bj][m][1];
#pragma unroll
                    for (int e = 0; e < 4; ++e) { o[e] = sigmoidf_(g[e]) * v0[e]; o[4 + e] = sigmoidf_(g[4 + e]) * v1[e]; }
                    bf16_t* dst = Mg + (size_t)row * D + col;
                    if (ACCUM) { const u32x4 ow = *(const u32x4*)dst; float od[8]; unpack8(ow, od);
#pragma unroll
                        for (int e = 0; e < 8; ++e) o[e] += od[e]; }
                    *(u32x4*)dst = pack8(o); } }
    }
};
struct EpiOut {
    static constexpr bool PERM = false;
    float* H;
    __device__ __forceinline__ void operator()(const f32x4 (&acc)[2][2][4][2], const pg8::Unit& u, int wr, int wc, int fr, int fq) const {
        const int row0 = u.pm * 256 + wr * 64 + fr, col0 = u.pn * 256 + wc * 32 + 4 * fq;
#pragma unroll
        for (int ai = 0; ai < 2; ++ai)
#pragma unroll
            for (int m = 0; m < 4; ++m) { float* rowp = H + (size_t)(row0 + ai * 128 + m * 16) * D + col0;
#pragma unroll
                for (int bj = 0; bj < 2; ++bj)
#pragma unroll
                    for (int n = 0; n < 2; ++n) { f32x4* ptr = (f32x4*)(rowp + bj * 128 + n * 16); *ptr = ALPHA * (*ptr) + acc[ai][bj][m][n]; } }
    }
};


template <int KS  >
__device__ __forceinline__ f32x4 meta_dot(const bf16_t* A  , const bf16_t* Bt  , int K, int ct, int k0, int fr, int fq) {
    f32x4 acc = (f32x4){0.f, 0.f, 0.f, 0.f};
    const bf16_t* ap = A + (size_t)fr * K + k0 + fq * 8; const bf16_t* bp = Bt + (size_t)(ct * 16 + fr) * K + k0 + fq * 8;
    bf16x8 a[KS / 32], b[KS / 32];
#pragma unroll
    for (int i = 0; i < KS / 32; ++i) { a[i] = *(const bf16x8*)(ap + i * 32); b[i] = *(const bf16x8*)(bp + i * 32); }
#pragma unroll
    for (int i = 0; i < KS / 32; ++i) acc = __builtin_amdgcn_mfma_f32_16x16x32_bf16(b[i], a[i], acc, 0, 0, 0);
    return acc;
}
__device__ __forceinline__ void meta_p4(const Params& P, int l, LAS unsigned char* lds, int wid, int lane) {
    if (blockIdx.x >= D / 16) return;
    const int ct = blockIdx.x, fr = lane & 15, fq = lane >> 4;
    const f32x4 ya = meta_dot<DA / 8>((const bf16_t*)(P.ws + WS_CO) + (size_t)NREAL * DA, (const bf16_t*)(P.ws + WS_WA) + (size_t)l * D * DA, DA, ct, wid * (DA / 8), fr, fq);
    const f32x4 yb = meta_dot<DB / 8>((const bf16_t*)(P.ws + WS_SB) + (size_t)NREAL * DB, (const bf16_t*)(P.ws + WS_WB) + (size_t)l * D * DB, DB, ct, wid * (DB / 8), fr, fq);
    LAS f32x4* red = (LAS f32x4*)lds;
    red[(wid * 2 + 0) * 64 + lane] = ya; red[(wid * 2 + 1) * 64 + lane] = yb;
    __syncthreads();
    if (wid == 0) {
        f32x4 sa = red[lane], sb2 = red[64 + lane];
#pragma unroll
        for (int w = 1; w < 8; ++w) { sa += red[(w * 2) * 64 + lane]; sb2 += red[(w * 2 + 1) * 64 + lane]; }
        const int row = NREAL + fr, c0 = ct * 16 + 4 * fq;
        const bf16_t* pr = (const bf16_t*)(P.ws + WS_P) + (size_t)row * NP;
        const u32x2 ga = *(const u32x2*)(pr + PC_GA + c0), gb = *(const u32x2*)(pr + PC_GB + c0);
        const float o0 = sigmoidf_(bf_lo(ga.x)) * sa[0] + sigmoidf_(bf_lo(gb.x)) * sb2[0], o1 = sigmoidf_(bf_hi(ga.x)) * sa[1] + sigmoidf_(bf_hi(gb.x)) * sb2[1];
        const float o2 = sigmoidf_(bf_lo(ga.y)) * sa[2] + sigmoidf_(bf_lo(gb.y)) * sb2[2], o3 = sigmoidf_(bf_hi(ga.y)) * sa[3] + sigmoidf_(bf_hi(gb.y)) * sb2[3];
        u32x2 w; w.x = cvt_pk_bf16(o0, o1); w.y = cvt_pk_bf16(o2, o3);
        *(u32x2*)((bf16_t*)(P.ws + WS_HB) + (size_t)row * D + c0) = w;
    }
}
__device__ __forceinline__ void meta_p5(const Params& P, int l, LAS unsigned char* lds, int wid, int lane) {
    if (blockIdx.x >= D / 16) return;
    const int ct = blockIdx.x, fr = lane & 15, fq = lane >> 4;
    const f32x4 acc = meta_dot<D / 8>((const bf16_t*)(P.ws + WS_HB) + (size_t)NREAL * D, (const bf16_t*)(P.ws + WS_WO) + (size_t)l * D * D, D, ct, wid * (D / 8), fr, fq);
    LAS f32x4* red = (LAS f32x4*)lds;
    red[wid * 64 + lane] = acc;
    __syncthreads();
    if (wid == 0) {
        f32x4 sa = red[lane];
#pragma unroll
        for (int w = 1; w < 8; ++w) sa += red[w * 64 + lane];
        f32x4* ptr = (f32x4*)((float*)(P.ws + WS_HF) + (size_t)(NREAL + fr) * D + ct * 16 + 4 * fq);
        *ptr = ALPHA * (*ptr) + sa;
    }
}

__device__ __forceinline__ void transpose_item(const float* W, int ldw, int src_n0, int k0, bf16_t* WT, int K, int dst_n0, LAS float* scr, int lane) {
    if (src_n0 >= 0) {
        f32x4 v[8]; const int n4 = (lane & 7) * 4;
#pragma unroll
        for (int i = 0; i < 8; ++i) v[i] = *(const f32x4*)(W + (size_t)(k0 + (lane >> 3) + 8 * i) * ldw + src_n0 + n4);
#pragma unroll
        for (int i = 0; i < 8; ++i) { LAS float* d = scr + ((lane >> 3) + 8 * i) * 33 + n4; d[0] = v[i].x; d[1] = v[i].y; d[2] = v[i].z; d[3] = v[i].w; }
    }
    asm volatile("s_waitcnt lgkmcnt(0)" ::: "memory");
    const int c = lane & 7;
#pragma unroll
    for (int j = 0; j < 4; ++j) { const int n = (lane >> 3) + 8 * j; const LAS float* s = scr + (8 * c) * 33 + n;
        u32x4 o = (u32x4){0u, 0u, 0u, 0u};
        if (src_n0 >= 0) { o.x = cvt_pk_bf16(s[0 * 33], s[1 * 33]); o.y = cvt_pk_bf16(s[2 * 33], s[3 * 33]); o.z = cvt_pk_bf16(s[4 * 33], s[5 * 33]); o.w = cvt_pk_bf16(s[6 * 33], s[7 * 33]); }
        *(u32x4*)(WT + (size_t)(dst_n0 + n) * K + k0 + 8 * c) = o; }
    asm volatile("s_waitcnt lgkmcnt(0)" ::: "memory");
}
__device__ __forceinline__ int win_src_col(int j) { return j < 12288 ? j : (j < 16384 ? j + 192 : (j < 16576 ? j - 4096 : -1)); }

__device__ __forceinline__ void convert_win(const Params& P, int l, LAS unsigned char* lds, int gw, int ngw, int wid, int lane) {
    LAS float* scr = (LAS float*)(lds + wid * 8448);
    const float* W = P.w_in + (size_t)l * D * NCOLS; bf16_t* WT = (bf16_t*)(P.ws + WS_WIN);
    constexpr int NBLK = NP / 32;
    for (int it = gw; it < (D / 64) * NBLK; it += ngw) { const int kb = it / NBLK, nb = it % NBLK;
        transpose_item(W, NCOLS, win_src_col(nb * 32), kb * 64, WT, D, nb * 32, scr, lane); }
}
__device__ __forceinline__ void convert_small(const Params& P, LAS unsigned char* lds, int gw, int ngw, int wid, int lane) {
    LAS float* scr = (LAS float*)(lds + wid * 8448);
    constexpr int IA = (DA / 64) * (D / 32), IB = (DB / 64) * (D / 32), IO = (D / 64) * (D / 32), IL = IA + IB + IO;
    for (int it = gw; it < DEPTH * IL; it += ngw) { const int l = it / IL; int r = it % IL;
        if (r < IA) { transpose_item(P.w_a + (size_t)l * DA * D, D, (r % (D / 32)) * 32, (r / (D / 32)) * 64, (bf16_t*)(P.ws + WS_WA) + (size_t)l * D * DA, DA, (r % (D / 32)) * 32, scr, lane); continue; } r -= IA;
        if (r < IB) { transpose_item(P.w_b + (size_t)l * DB * D, D, (r % (D / 32)) * 32, (r / (D / 32)) * 64, (bf16_t*)(P.ws + WS_WB) + (size_t)l * D * DB, DB, (r % (D / 32)) * 32, scr, lane); continue; } r -= IB;
        transpose_item(P.w_out + (size_t)l * D * D, D, (r % (D / 32)) * 32, (r / (D / 32)) * 64, (bf16_t*)(P.ws + WS_WO) + (size_t)l * D * D, D, (r % (D / 32)) * 32, scr, lane); }
    bf16_t* WL = (bf16_t*)(P.ws + WS_WL);
    const size_t tot = (size_t)DEPTH * 4096 * 32;
    for (size_t it = (size_t)gw * 64 + lane; it < tot; it += (size_t)ngw * 64) {
        const int n = (int)(it % 4096); const int kc = (int)((it / 4096) % 32) * 8; const int l = (int)(it / (4096 * 32));
        float f[8];
#pragma unroll
        for (int e = 0; e < 8; ++e) { const int k = kc + e; float v = 0.f;
            if (n < 2048) { if (k < LORA) v = P.w2[((size_t)l * LORA + k) * DB + n]; }
            else { if (k >= 128 && k < 128 + LORA) v = P.a2[((size_t)l * LORA + (k - 128)) * DB + (n - 2048)]; }
            f[e] = v; }
        *(u32x4*)(WL + ((size_t)l * 4096 + n) * 256 + kc) = pack8(f);
    }
}
__device__ __forceinline__ void ln_row(const float* src, const float* g, const float* b, float* dstf, bf16_t* dstb, int lane) {
    const f32x4* xr = (const f32x4*)src + lane;
    f32x4 v[8]; float s = 0.f;
#pragma unroll
    for (int j = 0; j < 8; ++j) { v[j] = xr[64 * j]; s += (v[j].x + v[j].y) + (v[j].z + v[j].w); }
    const float mean = wave_sum(s) * (1.f / D); float s2 = 0.f;
#pragma unroll
    for (int j = 0; j < 8; ++j) { v[j] = v[j] - mean; s2 += (v[j].x * v[j].x + v[j].y * v[j].y) + (v[j].z * v[j].z + v[j].w * v[j].w); }
    const float rstd = 1.f / sqrtf(wave_sum(s2) * (1.f / D) + LN_EPS);
#pragma unroll
    for (int j = 0; j < 8; ++j) { const f32x4 gg = ((const f32x4*)g)[lane + 64 * j], bb = ((const f32x4*)b)[lane + 64 * j];
        const f32x4 o = v[j] * rstd * gg + bb;
        if (dstf) ((f32x4*)dstf)[lane + 64 * j] = o;
        if (dstb) { u32x2 w; w.x = cvt_pk_bf16(o.x, o.y); w.y = cvt_pk_bf16(o.z, o.w); ((u32x2*)dstb)[lane + 64 * j] = w; } }
}
__device__ __forceinline__ void embed_phase(const Params& P, int gw, int ngw, int lane) {
    float* hf = (float*)(P.ws + WS_HF); bf16_t* hb = (bf16_t*)(P.ws + WS_HB);
    for (int r = gw; r < MPAD; r += ngw) {
        if (r < NROWS) { const float* src = r < NREAL ? P.x + (size_t)r * D : P.meta + (size_t)(r - NREAL) * D;
            ln_row(src, P.emb_g, P.emb_b, hf + (size_t)r * D, hb + (size_t)r * D, lane); }
        else {
#pragma unroll
            for (int j = 0; j < 8; ++j) { ((f32x4*)(hf + (size_t)r * D))[lane + 64 * j] = (f32x4){0.f, 0.f, 0.f, 0.f}; ((u32x2*)(hb + (size_t)r * D))[lane + 64 * j] = (u32x2){0u, 0u}; }
        }
    }
}
__device__ __forceinline__ void ln_phase(const Params& P, int l, int gw, int ngw, int lane) {
    float* hf = (float*)(P.ws + WS_HF); bf16_t* hb = (bf16_t*)(P.ws + WS_HB);
    const float* g = P.ln_g + (size_t)l * D; const float* b = P.ln_b + (size_t)l * D;
    if (l == DEPTH - 1) { for (int r = gw; r < NREAL; r += ngw) ln_row(hf + (size_t)r * D, g, b, P.out + (size_t)r * D, nullptr, lane); }
    else { for (int r = gw; r < NROWS; r += ngw) ln_row(hf + (size_t)r * D, g, b, hf + (size_t)r * D, hb + (size_t)r * D, lane); }
}

constexpr int RUN = 8, NRUN = NROWS / RUN;
__device__ __forceinline__ void p2_phase(const Params& P, int l, size_t gtid, size_t gthreads) {
    const bf16_t* p = (const bf16_t*)(P.ws + WS_P); bf16_t* co = (bf16_t*)(P.ws + WS_CO); bf16_t* al = (bf16_t*)(P.ws + WS_AL);
    const float* cw = P.conv_w + (size_t)l * 3 * DA; const float* mu = P.mu + (size_t)l * 8384;
    const size_t tot = (size_t)NRUN * 160;
    for (size_t it = gtid; it < tot; it += gthreads) {
        const int run = (int)(it / 160), ch = (int)(it % 160); const int row0 = run * RUN;
        const int r1 = prev_row(row0), r2 = r1 >= 0 ? prev_row(r1) : -1;
        if (ch < 128) {
            const int c0 = ch * 8;
            float w0[8], w1[8], w2[8], u1[8], u2[8], xa[8], xb[8];
#pragma unroll
            for (int e = 0; e < 8; ++e) { w0[e] = cw[c0 + e]; w1[e] = cw[DA + c0 + e]; w2[e] = cw[2 * DA + c0 + e]; u1[e] = 0.f; u2[e] = 0.f; }
            if (r1 >= 0) { const bf16_t* q = p + (size_t)r1 * NP; unpack8(*(const u32x4*)(q + PC_XIN + c0), xa); unpack8(*(const u32x4*)(q + PC_CG + c0), xb);
#pragma unroll
                for (int e = 0; e < 8; ++e) u1[e] = xa[e] * xb[e]; }
            if (r2 >= 0) { const bf16_t* q = p + (size_t)r2 * NP; unpack8(*(const u32x4*)(q + PC_XIN + c0), xa); unpack8(*(const u32x4*)(q + PC_CG + c0), xb);
#pragma unroll
                for (int e = 0; e < 8; ++e) u2[e] = xa[e] * xb[e]; }
            u32x4 Lx[RUN], Lc[RUN], Lb[RUN], Lz[RUN];
#pragma unroll
            for (int rr = 0; rr < RUN; ++rr) { const bf16_t* pr = p + (size_t)(row0 + rr) * NP + c0; Lx[rr] = *(const u32x4*)(pr + PC_XIN); Lc[rr] = *(const u32x4*)(pr + PC_CG); Lb[rr] = *(const u32x4*)(pr + PC_BG); Lz[rr] = *(const u32x4*)(pr + PC_ZA); }
#pragma unroll
            for (int rr = 0; rr < RUN; ++rr) {
                float bg[8], z[8], o[8], u0[8]; unpack8(Lx[rr], xa); unpack8(Lc[rr], xb); unpack8(Lb[rr], bg); unpack8(Lz[rr], z);
#pragma unroll
                for (int e = 0; e < 8; ++e) { u0[e] = xa[e] * xb[e]; const float cv = w0[e] * u2[e] + w1[e] * u1[e] + w2[e] * u0[e]; o[e] = bg[e] * cv * siluf_(z[e]); u2[e] = u1[e]; u1[e] = u0[e]; }
                *(u32x4*)(co + (size_t)(row0 + rr) * DA + c0) = pack8(o);
            }
        } else {
            const int kc = (ch - 128) * 8;
            const bool isw = kc < LORA, isa = (kc >= 128 && kc < 128 + LORA);
            if (isw || isa) {
                const int pc = isw ? PC_WLO + kc : PC_ALO + (kc - 128); const int mi = isw ? 8192 + kc : 8288 + (kc - 128);
                float m[8], q[8], c[8], o[8];
#pragma unroll
                for (int e = 0; e < 8; ++e) { m[e] = mu[mi + e]; q[e] = 0.f; }
                if (r1 >= 0) unpack8(*(const u32x4*)(p + (size_t)r1 * NP + pc), q);
                u32x4 Lc[RUN];
#pragma unroll
                for (int rr = 0; rr < RUN; ++rr) Lc[rr] = *(const u32x4*)(p + (size_t)(row0 + rr) * NP + pc);
#pragma unroll
                for (int rr = 0; rr < RUN; ++rr) { unpack8(Lc[rr], c);
#pragma unroll
                    for (int e = 0; e < 8; ++e) { const float v = c[e] + m[e] * (q[e] - c[e]); o[e] = isw ? tanhf(v) : v; q[e] = c[e]; }
                    *(u32x4*)(al + (size_t)(row0 + rr) * 256 + kc) = pack8(o); }
            } else {
#pragma unroll
                for (int rr = 0; rr < RUN; ++rr) *(u32x4*)(al + (size_t)(row0 + rr) * 256 + kc) = (u32x4){0u, 0u, 0u, 0u};
            }
        }
    }
}

constexpr int TC = 32, NCH = 1 + SEQ / TC;
constexpr int REC = 1280;
constexpr int SC_OPND = 0, SC_V = TC * REC, SC_Y = SC_V + TC * 16 * 8, SC_BUF = SC_Y + TC * 16 * 4;
#define SCAN_BARRIER() do { asm volatile("s_waitcnt lgkmcnt(0)" ::: "memory"); __builtin_amdgcn_s_barrier(); asm volatile("" ::: "memory"); } while (0)
__device__ __forceinline__ void scan_phase(const Params& P, int l, LAS unsigned char* lds, const int tid) {
    const int wid = __builtin_amdgcn_readfirstlane(tid >> 6), lane = tid & 63;
    const bf16_t* p = (const bf16_t*)(P.ws + WS_P); const unsigned short* xb = (const unsigned short*)(P.ws + WS_HB); const unsigned short* ab = (const unsigned short*)(P.ws + WS_AB);
    bf16_t* sb = (bf16_t*)(P.ws + WS_SB); float* bon = (float*)(P.ws + WS_BON);
    for (int item = blockIdx.x; item < 256; item += gridDim.x) {
        const int xcd_ = item & 7, y_ = item >> 3, hh_ = xcd_ * 8 + (y_ >> 2);
        const int b = hh_ >> 5, h = hh_ & 31, q = y_ & 3;
        const int j = tid & 255, tt = j >> 3, cgp = j & 7, c0 = h * 64 + cgp * 8;
        const bool vown = (cgp >> 1) == q;
        u32x4 LAr0, LAr1, LAk0, LAk1, LAv0, LAv1, LAx, LAa, LBr0, LBr1, LBk0, LBk1, LBv0, LBv1, LBx, LBa;
        LAr0 = LAr1 = LAk0 = LAk1 = LAv0 = LAv1 = LAx = LAa = LBr0 = LBr1 = LBk0 = LBk1 = LBv0 = LBv1 = LBx = LBa = (u32x4){0u, 0u, 0u, 0u};
        const int rl = lane >> 4, kq = lane & 15, rowl = (wid & 3) * 4 + rl;
        f32x2 s01 = (f32x2){0.f, 0.f}, s23 = (f32x2){0.f, 0.f}; float yacc = 0.f;
#define CHUNK_ROW(c, t) ((c) == 0 ? NREAL + (t) : b * SEQ + ((c) - 1) * TC + (t))
#define ISSUE_LOADS(L, c) do { const bool valid_ = ((c) > 0) || (tt < NMETA); if (valid_) { const int row_ = CHUNK_ROW(c, tt); const int pr_ = prev_row(row_); \
            const bf16_t* a_ = p + (size_t)row_ * NP + c0; L##r0 = *(const u32x4*)(a_ + PC_R); L##k0 = *(const u32x4*)(a_ + PC_K); if (vown) L##v0 = *(const u32x4*)(a_ + PC_V); \
            L##x = *(const u32x4*)(xb + (size_t)row_ * DB + c0); L##a = *(const u32x4*)(ab + (size_t)row_ * DB + c0); \
            if (pr_ >= 0) { const bf16_t* a1_ = p + (size_t)pr_ * NP + c0; L##r1 = *(const u32x4*)(a1_ + PC_R); L##k1 = *(const u32x4*)(a1_ + PC_K); if (vown) L##v1 = *(const u32x4*)(a1_ + PC_V); } \
            else { L##r1 = L##k1 = L##v1 = (u32x4){0u, 0u, 0u, 0u}; } } } while (0)
        if (wid >= 4) {
            if (j < 96) {
                const float* mu = P.mu + (size_t)l * 8384; const int arr = j >> 4, c4 = h * 64 + (j & 15) * 4;
                const float* src = arr == 0 ? mu + c4 : arr == 1 ? mu + 2048 + c4 : arr == 2 ? mu + 4096 + c4 : arr == 3 ? P.kks + (size_t)l * DB + c4 : arr == 4 ? P.kas + (size_t)l * DB + c4 : P.rk + (size_t)l * DB + c4;
                ((LAS f32x4*)(lds + 2 * SC_BUF))[j] = *(const f32x4*)src;
            }
            ISSUE_LOADS(LA, 0); ISSUE_LOADS(LB, 1);
        } else {
            __builtin_amdgcn_s_setprio(2);
        }
        __syncthreads();
        float mur[8], muk[8], kks[8], kas[8], rks[8], muv[8];
        { LAS const f32x4* cst_ = (LAS const f32x4*)(lds + 2 * SC_BUF) + cgp * 2;
#pragma unroll
          for (int e = 0; e < 4; ++e) { muv[e] = cst_[32][e]; muv[4 + e] = cst_[33][e]; mur[e] = cst_[0][e]; mur[4 + e] = cst_[1][e]; muk[e] = cst_[16][e]; muk[4 + e] = cst_[17][e]; kks[e] = cst_[48][e]; kks[4 + e] = cst_[49][e];
              kas[e] = cst_[64][e]; kas[4 + e] = cst_[65][e]; rks[e] = cst_[80][e]; rks[4 + e] = cst_[81][e]; } }
#define SCAN_ITER(L, i) do { \
            if (wid >= 4) { \
                if ((i) >= 2 && (i) - 2 < NCH) {     \
                    const int c = (i) - 2; const bool valid = (c > 0) ? true : (tt < NMETA && b == 0); \
                    if (valid) { const LAS f32x2* yb = (const LAS f32x2*)(lds + ((i) & 1) * SC_BUF + SC_Y + tt * 64) + cgp; const f32x2 y = *yb; \
                        const f32x4 vc_ = *((const LAS f32x4*)(lds + ((i) & 1) * SC_BUF + SC_V + tt * 128) + cgp); \
                        *(unsigned*)(sb + (size_t)CHUNK_ROW(c, tt) * DB + h * 64 + q * 16 + 2 * cgp) = cvt_pk_bf16(y.x + vc_.y, y.y + vc_.w); } \
                } \
                if ((i) < NCH) { \
                    LAS unsigned char* buf = lds + ((i) & 1) * SC_BUF; \
                    const bool valid = ((i) > 0) || (tt < NMETA); \
                    float r0[8], r1[8], k0[8], k1[8], xx[8], aa[8]; \
                    unpack8(L##r0, r0); unpack8(L##r1, r1); unpack8(L##k0, k0); unpack8(L##k1, k1); unpack8h(L##x, xx); unpack8h(L##a, aa); \
                    float rr[8], kp[8], kkv[8], dec[8]; float ss = 0.f; \
                    _Pragma("unroll") for (int e = 0; e < 8; ++e) { rr[e] = r0[e] + mur[e] * (r1[e] - r0[e]); kp[e] = k0[e] + muk[e] * (k1[e] - k0[e]); dec[e] = __expf(-xx[e]); \
                        kkv[e] = kp[e] * kks[e]; ss += kkv[e] * kkv[e]; } \
                    ss = allred8(ss); \
                    const float inv = __builtin_amdgcn_rsqf(fmaxf(ss, 1e-24f)); \
                    float kk[8], kka[8], kt[8], wr[8]; float bs = 0.f, c1 = 0.f, c2 = 0.f; \
                    _Pragma("unroll") for (int e = 0; e < 8; ++e) { kk[e] = kkv[e] * inv; kka[e] = kk[e] * aa[e]; kt[e] = kp[e] * (1.0f + (aa[e] - 1.0f) * kas[e]); bs += rr[e] * kt[e] * rks[e]; \
                        wr[e] = dec[e] * rr[e]; c1 += kka[e] * rr[e]; c2 += kt[e] * rr[e]; } \
                    bs = allred8(bs); c1 = allred8(c1); c2 = allred8(c2); \
                    if (valid) { \
                        LAS f32x4* o = (LAS f32x4*)(buf + SC_OPND + tt * REC) + cgp * 2; \
                        float rp[8]; _Pragma("unroll") for (int e = 0; e < 8; ++e) rp[e] = wr[e] - c1 * kk[e]; \
                        o[0] = (f32x4){kk[0], rp[0], kk[1], rp[1]}; o[1] = (f32x4){kk[4], rp[4], kk[5], rp[5]}; \
                        o[16] = (f32x4){kk[2], rp[2], kk[3], rp[3]}; o[17] = (f32x4){kk[6], rp[6], kk[7], rp[7]}; \
                        o[32] = (f32x4){dec[0], dec[1], dec[2], dec[3]}; o[33] = (f32x4){dec[4], dec[5], dec[6], dec[7]}; \
                        o[48] = (f32x4){kka[0], kka[1], kka[2], kka[3]}; o[49] = (f32x4){kka[4], kka[5], kka[6], kka[7]}; \
                        o[64] = (f32x4){kt[0], kt[1], kt[2], kt[3]}; o[65] = (f32x4){kt[4], kt[5], kt[6], kt[7]}; \
                        if (vown) { float v0[8], v1[8]; unpack8(L##v0, v0); unpack8(L##v1, v1); \
                            LAS f32x4* vo = (LAS f32x4*)(buf + SC_V + tt * 128) + (cgp & 1) * 4; \
                            float vv[8]; \
                            _Pragma("unroll") for (int e = 0; e < 8; ++e) vv[e] = v0[e] + muv[e] * (v1[e] - v0[e]); \
                            vo[0] = (f32x4){vv[0], vv[0] * c2, vv[1], vv[1] * c2}; vo[1] = (f32x4){vv[2], vv[2] * c2, vv[3], vv[3] * c2}; \
                            vo[2] = (f32x4){vv[4], vv[4] * c2, vv[5], vv[5] * c2}; vo[3] = (f32x4){vv[6], vv[6] * c2, vv[7], vv[7] * c2}; } \
                        if (q == 0 && cgp == 0 && ((i) > 0 || b == 0)) bon[(size_t)CHUNK_ROW(i, tt) * 32 + h] = bs; \
                    } \
                } \
                if ((i) + 2 < NCH) ISSUE_LOADS(L, (i) + 2); \
            } else { \
                if ((i) >= 1 && (i) <= NCH) { \
                    const int c = (i) - 1; const int ntok = c == 0 ? NMETA : TC; \
                    LAS const unsigned char* buf = lds + (c & 1) * SC_BUF; \
                    LAS float* ybuf = (LAS float*)(lds + (c & 1) * SC_BUF + SC_Y) + (15 - kq) * 16 + rowl; \
                    f32x4 Akra, Akrb, Aw, Aka, Ak, Bkra, Bkrb, Bw, Bka, Bk; f32x2 Av, Bv; \
                    LAS const unsigned char* ob = buf + SC_OPND + kq * 16; LAS const unsigned char* vb = buf + SC_V + rowl * 8; \
                    LOADOPS(A, 0); \
                    _Pragma("unroll 1") for (int g = 0; g < ntok; g += 16) { \
                        asm volatile("" : "+v"(ob), "+v"(vb));     \
                        _Pragma("unroll") for (int u = 0; u < 8; ++u) { LOADOPS(B, 2 * u + 1); STEP(A); LOADOPS(A, 2 * u + 2); STEP(B); } \
                        ob += 16 * REC; vb += 16 * 128; \
                        ybuf[g * 16] = yacc; } \
                } \
            } \
            SCAN_BARRIER(); } while (0)
#define LOADOPS(S, t) do { S##kra = *(LAS const f32x4*)(ob + (t) * REC); S##krb = *(LAS const f32x4*)(ob + (t) * REC + 256); S##w = *(LAS const f32x4*)(ob + (t) * REC + 512); \
                        S##ka = *(LAS const f32x4*)(ob + (t) * REC + 768); S##k = *(LAS const f32x4*)(ob + (t) * REC + 1024); S##v = *(LAS const f32x2*)(vb + (t) * 128); } while (0)
#define LO2(v) __builtin_shufflevector(v, v, 0, 1)
#define HI2(v) __builtin_shufflevector(v, v, 2, 3)
#define STEP(S) do { \
                        f32x2 P_ = (f32x2){s01.x, s01.x} * LO2(S##kra); \
                        P_ = (f32x2){s01.y, s01.y} * HI2(S##kra) + P_; \
                        P_ = (f32x2){s23.x, s23.x} * LO2(S##krb) + P_; \
                        P_ = (f32x2){s23.y, s23.y} * HI2(S##krb) + P_; \
                        float sa_ = P_.x, yp_ = P_.y; \
                        f32x2 m01_ = s01 * LO2(S##w), m23_ = s23 * HI2(S##w); \
                        sa_ += dpp_mov<0xB1>(sa_); yp_ += dpp_mov<0xB1>(yp_); \
                        m01_ = (f32x2){S##v.x, S##v.x} * LO2(S##k) + m01_; \
                        sa_ += dpp_mov<0x4E>(sa_); yp_ += dpp_mov<0x4E>(yp_); \
                        m23_ = (f32x2){S##v.x, S##v.x} * HI2(S##k) + m23_; \
                        sa_ += dpp_mov<0x141>(sa_); yp_ += dpp_mov<0x141>(yp_); sa_ += dpp_mov<0x128>(sa_); yp_ += dpp_mov<0x128>(yp_); \
                        const f32x2 sa2_ = (f32x2){sa_, sa_}; \
                        s01 = m01_ - sa2_ * LO2(S##ka); s23 = m23_ - sa2_ * HI2(S##ka); \
                        yacc = __builtin_bit_cast(float, __builtin_amdgcn_update_dpp(__builtin_bit_cast(int, yp_), __builtin_bit_cast(int, yacc), 0x111, 0xf, 0xf, false)); } while (0)
#pragma unroll 1
        for (int i = 0; i < NCH + 2; i += 2) { SCAN_ITER(LA, i); SCAN_ITER(LB, i + 1); }
        if (wid < 4) __builtin_amdgcn_s_setprio(0);
        __syncthreads();
    }
}

__device__ __forceinline__ void p3b_phase(const Params& P, int l, size_t gtid, size_t gthreads) {
    const bf16_t* p = (const bf16_t*)(P.ws + WS_P); bf16_t* sb = (bf16_t*)(P.ws + WS_SB); const float* bon = (const float*)(P.ws + WS_BON);
    const float* mu = P.mu + (size_t)l * 8384; const float* gg = P.gn_g + (size_t)l * DB; const float* gb = P.gn_b + (size_t)l * DB;
    const size_t tot = (size_t)NRUN * 256;
    for (size_t it = gtid; it < tot; it += gthreads) {
        const int run = (int)(it >> 8), h = (int)((it >> 3) & 31), c0 = h * 64 + (int)(it & 7) * 8; const int row0 = run * RUN; const int r1 = prev_row(row0);
        float mv[8], mz[8], g8[8], b8[8], v1[8], z1[8];
#pragma unroll
        for (int e = 0; e < 8; ++e) { mv[e] = mu[4096 + c0 + e]; mz[e] = mu[6144 + c0 + e]; g8[e] = gg[c0 + e]; b8[e] = gb[c0 + e]; v1[e] = 0.f; z1[e] = 0.f; }
        if (r1 >= 0) { unpack8(*(const u32x4*)(p + (size_t)r1 * NP + PC_V + c0), v1); unpack8(*(const u32x4*)(p + (size_t)r1 * NP + PC_Z + c0), z1); }
        u32x4 Ly[RUN], Lv[RUN], Lz[RUN]; float Lb[RUN];
#pragma unroll
        for (int rr = 0; rr < RUN; ++rr) { const size_t row = (size_t)(row0 + rr); Ly[rr] = *(const u32x4*)(sb + row * DB + c0); Lv[rr] = *(const u32x4*)(p + row * NP + PC_V + c0); Lz[rr] = *(const u32x4*)(p + row * NP + PC_Z + c0); Lb[rr] = bon[row * 32 + h]; }
#pragma unroll
        for (int rr = 0; rr < RUN; ++rr) {
            float y[8], v0[8], z0[8], o[8]; unpack8(Ly[rr], y); unpack8(Lv[rr], v0); unpack8(Lz[rr], z0);
            float s1 = 0.f;
#pragma unroll
            for (int e = 0; e < 8; ++e) s1 += y[e];
            const float mean = allred8(s1) * (1.f / 64.f); float s2 = 0.f;
#pragma unroll
            for (int e = 0; e < 8; ++e) { y[e] -= mean; s2 += y[e] * y[e]; }
            const float rstd = __builtin_amdgcn_rsqf(allred8(s2) * (1.f / 64.f) + GN_EPS); const float bs = Lb[rr];
#pragma unroll
            for (int e = 0; e < 8; ++e) { const float vp = v0[e] + mv[e] * (v1[e] - v0[e]); const float zp = z0[e] + mz[e] * (z1[e] - z0[e]);
                o[e] = (y[e] * rstd * g8[e] + b8[e] + bs * vp) * siluf_(zp); v1[e] = v0[e]; z1[e] = z0[e]; }
            *(u32x4*)(sb + (size_t)(row0 + rr) * DB + c0) = pack8(o);
        }
    }
}

constexpr size_t WS_DBG = WS_END;
__device__ __forceinline__ void dbg_fail(const Params& P, unsigned bit) { atomicOr((unsigned*)(P.ws + WS_DBG), bit); }
__device__ __forceinline__ float bf2f(bf16_t v) { return __uint_as_float((unsigned)v << 16); }
__device__ __forceinline__ float h2f(unsigned short v) { return (float)__builtin_bit_cast(_Float16, v); }
__device__ __forceinline__ void chk_gemm1(const Params& P, int gw, int ngw, int lane) {
    const bf16_t* hb = (const bf16_t*)(P.ws + WS_HB); const bf16_t* wt = (const bf16_t*)(P.ws + WS_WIN); const bf16_t* p = (const bf16_t*)(P.ws + WS_P);
    for (int i = gw; i < 4096; i += ngw) { const int row = (int)(((long)i * 977) % NROWS), col = (int)(((long)i * 613) % NP);
        float s = 0.f; for (int k = lane; k < D; k += 64) s += bf2f(hb[(size_t)row * D + k]) * bf2f(wt[(size_t)col * D + k]);
        s = wave_sum(s); const float got = bf2f(p[(size_t)row * NP + col]);
        if (lane == 0 && !(fabsf(got - s) <= 0.03f + 0.02f * fabsf(s))) dbg_fail(P, 1u); }
}
__device__ __forceinline__ void chk_lora(const Params& P, int l, int gw, int ngw, int lane) {
    const bf16_t* al = (const bf16_t*)(P.ws + WS_AL); const bf16_t* wl = (const bf16_t*)(P.ws + WS_WL) + (size_t)l * 4096 * 256;
    const unsigned short* xb = (const unsigned short*)(P.ws + WS_HB); const unsigned short* ab = (const unsigned short*)(P.ws + WS_AB);
    for (int i = gw; i < 4096; i += ngw) { const int row = (int)(((long)i * 977) % NROWS), c = (int)(((long)i * 613) % DB);
        float s1 = 0.f, s2 = 0.f; for (int k = lane; k < 256; k += 64) { const float av = bf2f(al[(size_t)row * 256 + k]); s1 += av * bf2f(wl[(size_t)c * 256 + k]); s2 += av * bf2f(wl[(size_t)(2048 + c) * 256 + k]); }
        s1 = wave_sum(s1); s2 = wave_sum(s2);
        const float xr = 0.60653065971f / (1.f + expf(-(P.w0[(size_t)l * DB + c] + s1))), ar = 1.f / (1.f + expf(-(P.a0[(size_t)l * DB + c] + s2)));
        const float xg = h2f(xb[(size_t)row * DB + c]), ag = h2f(ab[(size_t)row * DB + c]);
        if (lane == 0 && !(fabsf(xg - xr) <= 1e-4f + 0.01f * fabsf(xr))) dbg_fail(P, 2u);
        if (lane == 0 && !(fabsf(ag - ar) <= 1e-3f + 0.01f * fabsf(ar))) dbg_fail(P, 4u); }
}
__device__ __forceinline__ void chk_scan(const Params& P, int l, LAS unsigned char* lds, int gw, int wid, int lane) {
    if (gw >= 8) return;
    const int b = gw & 1, h = (gw * 5 + 3) & 31;
    LAS float* S = (LAS float*)(lds + wid * 16384); LAS float* op = S + 64 * 49;
    const bf16_t* p = (const bf16_t*)(P.ws + WS_P); const unsigned short* xb = (const unsigned short*)(P.ws + WS_HB); const unsigned short* ab = (const unsigned short*)(P.ws + WS_AB);
    const bf16_t* sb = (const bf16_t*)(P.ws + WS_SB); const float* bon = (const float*)(P.ws + WS_BON);
    const float* mu = P.mu + (size_t)l * 8384; const int c = h * 64 + lane;
    (void)S; (void)op;
    LAS float* st = S + lane * 64;
    for (int k = 0; k < 64; ++k) st[(k + lane) & 63] = 0.f;
    const float mur = mu[c], muk = mu[2048 + c], muv = mu[4096 + c], kks = P.kks[(size_t)l * DB + c], kas = P.kas[(size_t)l * DB + c], rks = P.rk[(size_t)l * DB + c];
    for (int tau = 0; tau < 16 + 40; ++tau) {
        const int row = tau < 16 ? NREAL + tau : b * SEQ + (tau - 16); const int pr = prev_row(row);
        const float r0 = bf2f(p[(size_t)row * NP + PC_R + c]), k0 = bf2f(p[(size_t)row * NP + PC_K + c]), v0 = bf2f(p[(size_t)row * NP + PC_V + c]);
        const float r1 = pr >= 0 ? bf2f(p[(size_t)pr * NP + PC_R + c]) : 0.f, k1 = pr >= 0 ? bf2f(p[(size_t)pr * NP + PC_K + c]) : 0.f, v1 = pr >= 0 ? bf2f(p[(size_t)pr * NP + PC_V + c]) : 0.f;
        const float rr = r0 + mur * (r1 - r0), kp = k0 + muk * (k1 - k0), vp = v0 + muv * (v1 - v0);
        const float x = h2f(xb[(size_t)row * DB + c]), a = h2f(ab[(size_t)row * DB + c]);
        const float w = expf(-x); const float kkv = kp * kks; const float nrm = sqrtf(wave_sum(kkv * kkv)); const float kk = kkv / fmaxf(nrm, 1e-12f);
        const float kka = kk * a, kt = kp * (1.f + (a - 1.f) * kas);
        const float bs = wave_sum(rr * kt * rks);
        float sa = 0.f;
#pragma unroll 1
        for (int k = 0; k < 64; ++k) sa += st[(k + lane) & 63] * __shfl(kk, k);
        float y = 0.f;
#pragma unroll 1
        for (int k = 0; k < 64; ++k) { const float nv = st[(k + lane) & 63] * __shfl(w, k) - sa * __shfl(kka, k) + vp * __shfl(kt, k); st[(k + lane) & 63] = nv; y += nv * __shfl(rr, k); }
        if (tau >= 16 || b == 0) {
            const float yg = bf2f(sb[(size_t)row * DB + c]);
            if (!(fabsf(yg - y) <= 0.02f + 0.02f * fabsf(y))) dbg_fail(P, 8u);
            if (lane == 0 && !(fabsf(bon[(size_t)row * 32 + h] - bs) <= 1e-3f + 1e-3f * fabsf(bs))) dbg_fail(P, 16u);
        }
    }
}
__device__ __forceinline__ void chk_merged(const Params& P, int l, int gw, int ngw, int lane) {
    const bf16_t* co = (const bf16_t*)(P.ws + WS_CO); const bf16_t* sb = (const bf16_t*)(P.ws + WS_SB); const bf16_t* p = (const bf16_t*)(P.ws + WS_P); const bf16_t* mg = (const bf16_t*)(P.ws + WS_HB);
    const bf16_t* wa = (const bf16_t*)(P.ws + WS_WA) + (size_t)l * D * DA; const bf16_t* wb = (const bf16_t*)(P.ws + WS_WB) + (size_t)l * D * DB;
    for (int i = gw; i < 4096; i += ngw) { const int row = (int)(((long)i * 977) % NROWS), c = (int)(((long)i * 613) % D);
        float s1 = 0.f, s2 = 0.f; for (int k = lane; k < DA; k += 64) s1 += bf2f(co[(size_t)row * DA + k]) * bf2f(wa[(size_t)c * DA + k]);
        for (int k = lane; k < DB; k += 64) s2 += bf2f(sb[(size_t)row * DB + k]) * bf2f(wb[(size_t)c * DB + k]);
        s1 = wave_sum(s1); s2 = wave_sum(s2);
        const float ga = 1.f / (1.f + expf(-bf2f(p[(size_t)row * NP + PC_GA + c]))), gb = 1.f / (1.f + expf(-bf2f(p[(size_t)row * NP + PC_GB + c])));
        const float m = ga * s1 + gb * s2, got = bf2f(mg[(size_t)row * D + c]);
        if (lane == 0 && !(fabsf(got - m) <= 0.01f + 0.03f * fabsf(m))) dbg_fail(P, 32u); }
}

#define XB_TMO      128
#define XB_XCNT(j)  (256  + 64 * (j))
#define XB_XSUB(j)  (1280 + 64 * (j))
#define XB_XGEN(j)  (2304 + 64 * (j))
#define XB_TOP      3328
#define XB_TOPGEN   3392
#define XCD_BAR_WORDS 3456
#define XB_SPIN_CAP (1u << 18)
__device__ __forceinline__ unsigned xb_ld(unsigned* p)              { return __hip_atomic_load(p, __ATOMIC_RELAXED, __HIP_MEMORY_SCOPE_AGENT); }
__device__ __forceinline__ unsigned xb_add(unsigned* p, unsigned v) { return __hip_atomic_fetch_add(p, v, __ATOMIC_RELAXED, __HIP_MEMORY_SCOPE_AGENT); }
__device__ __forceinline__ unsigned xb_xcc_id() { return (unsigned)__builtin_amdgcn_s_getreg((3 << 11) | 20) & 0xFu; }
#define XB_SPIN(cond, bar) do { unsigned _sp = 0; while (cond) { __builtin_amdgcn_s_sleep(1); \
    if ((++_sp & 255u) == 0u) { if (xb_ld(&(bar)[XB_TMO])) break; if (_sp > XB_SPIN_CAP) { atomicAdd(&(bar)[XB_TMO], 1u); break; } } } } while (0)
struct XcdBarrier { unsigned* bar; unsigned x; volatile LAS unsigned* st; };
__device__ __forceinline__ void xcd_barrier_complete(unsigned* bar, unsigned x, unsigned& nloc, unsigned& nx) {
    const unsigned G = gridDim.x * gridDim.y * gridDim.z;
    unsigned sum, cnt, mine, sp = 0u;
    for (;;) {
        sum = 0u; cnt = 0u; mine = 0u;
#pragma unroll
        for (unsigned j = 0; j < 16; ++j) { const unsigned c = xb_ld(&bar[XB_XCNT(j)]); sum += c; cnt += (c > 0u) ? 1u : 0u; mine = (j == x) ? c : mine; }
        if (sum == G) break;
        __builtin_amdgcn_s_sleep(1);
        if ((++sp & 255u) == 0u) { if (xb_ld(&bar[XB_TMO])) break; if (sp > XB_SPIN_CAP) { atomicAdd(&bar[XB_TMO], 1u); break; } }
    }
    nloc = mine > 0u ? mine : 1u; nx = cnt > 0u ? cnt : 1u;
}
__device__ __forceinline__ void xcd_barrier(const XcdBarrier& b) {
    asm volatile("s_waitcnt vmcnt(0)" ::: "memory");
    __syncthreads();
    if (threadIdx.x == 0) {
        unsigned* bar = b.bar;
        __builtin_amdgcn_s_waitcnt(0);
        unsigned nloc = b.st[0], nx = b.st[1];
        if (nloc == 0u) { xcd_barrier_complete(bar, b.x, nloc, nx); b.st[0] = nloc; b.st[1] = nx; }
        const unsigned old = xb_add(&bar[XB_XSUB(b.x)], 1u);
        const unsigned gen = old / nloc;
        if (old + 1u == (gen + 1u) * nloc) {
            __builtin_amdgcn_fence(__ATOMIC_RELEASE, "agent");
            asm volatile("s_waitcnt vmcnt(0)" ::: "memory");
            const unsigned og = xb_add(&bar[XB_TOP], 1u);
            const unsigned tg = og / nx;
            if (og + 1u == (tg + 1u) * nx) xb_add(&bar[XB_TOPGEN], 1u);
            else XB_SPIN(xb_ld(&bar[XB_TOPGEN]) == tg, bar);
            __builtin_amdgcn_fence(__ATOMIC_ACQUIRE, "agent");
            xb_add(&bar[XB_XGEN(b.x)], 1u);
            asm volatile("s_waitcnt vmcnt(0)" ::: "memory");
        } else {
            XB_SPIN(xb_ld(&bar[XB_XGEN(b.x)]) == gen, bar);
            __builtin_amdgcn_fence(__ATOMIC_ACQUIRE, "agent");
            asm volatile("s_waitcnt vmcnt(0)" ::: "memory");
        }
    }
    __syncthreads();
}
constexpr size_t WS_BAR = WS_END + 4096;
constexpr int LDS_XB = 131072;
#define LAUNDER(v) asm volatile("" : "+v"(v))
#if defined(__HIP_DEVICE_COMPILE__)
#define GETPARAMS const Params P = *Pp
#else
#define GETPARAMS const Params P = Pformal
#endif
__global__ void __launch_bounds__(512, 2) fwd_megakernel(Params Pformal) {
    extern __shared__ __attribute__((aligned(16))) unsigned char shm[];
    LAS unsigned char* lds = (LAS unsigned char*)shm;
    cg::grid_group grid = cg::this_grid();
    const int G = gridDim.x;
#if defined(__HIP_DEVICE_COMPILE__)
#define WS_PTR() (((const __attribute__((address_space(4))) Params*)__builtin_amdgcn_kernarg_segment_ptr())->ws)
#else
#define WS_PTR() (Pformal.ws)
#endif
#define GRID_BAR() do { XcdBarrier b_; b_.bar = (unsigned*)(WS_PTR() + WS_BAR); b_.x = xb_xcc_id(); b_.st = (volatile LAS unsigned*)(lds + LDS_XB); xcd_barrier(b_); } while (0)
    { unsigned* bar0 = (unsigned*)(WS_PTR() + WS_BAR); for (int i = blockIdx.x * 512 + threadIdx.x; i < XCD_BAR_WORDS; i += G * 512) bar0[i] = 0u;
      if (threadIdx.x == 0) { ((volatile LAS unsigned*)(lds + LDS_XB))[0] = 0u; ((volatile LAS unsigned*)(lds + LDS_XB))[1] = 0u; } }
#define TIDS() const __attribute__((address_space(4))) Params* Pp = (const __attribute__((address_space(4))) Params*)__builtin_amdgcn_kernarg_segment_ptr(); asm volatile("" : "+s"(Pp)); GETPARAMS; \
    bf16_t* hb = (bf16_t*)(P.ws + WS_HB); bf16_t* pbuf = (bf16_t*)(P.ws + WS_P); (void)hb; (void)pbuf; \
    int tid = threadIdx.x; LAUNDER(tid); const int wid = __builtin_amdgcn_readfirstlane(tid >> 6), lane = tid & 63; const int gw = blockIdx.x * 8 + wid, ngw = G * 8; (void)lane; (void)gw; (void)ngw
    { TIDS();
#ifdef DBG_CHECKS
      if (blockIdx.x == 0 && tid == 0) *(unsigned*)(P.ws + WS_DBG) = 0u;
#endif
      convert_small(P, lds, gw, ngw, wid, lane); }
    { TIDS(); convert_win(P, 0, lds, gw, ngw, wid, lane); }
    { TIDS(); embed_phase(P, gw, ngw, lane); }
    grid.sync();
    if (threadIdx.x == 0) (void)xb_add(&((unsigned*)(WS_PTR() + WS_BAR))[XB_XCNT(xb_xcc_id())], 1u);
    for (int l = 0; l < DEPTH; ++l) {
        {
            TIDS();
            pg8::Gemm g{hb, (const bf16_t*)(P.ws + WS_WIN), MPAD, NP, D}; pg8::StaticOrder S; S.init(MPAD, NP, G, blockIdx.x);
            EpiP E{pbuf}; pg8::gemm_run(lds, g, S, E, tid);
        }
        GRID_BAR();
#ifdef DBG_CHECKS
        if (l == 0) { TIDS(); chk_gemm1(P, gw, ngw, lane); }
#endif
        { TIDS(); p2_phase(P, l, (size_t)blockIdx.x * 512 + tid, (size_t)G * 512); }
        GRID_BAR();
        {
            TIDS();
            pg8::Gemm g{(const bf16_t*)(P.ws + WS_AL), (const bf16_t*)(P.ws + WS_WL) + (size_t)l * 4096 * 256, MPAD, 4096, 256}; pg8::StaticOrder S; S.init(MPAD, 4096, G, blockIdx.x);
            EpiLora E{(unsigned short*)(P.ws + WS_HB), (unsigned short*)(P.ws + WS_AB), P.w0 + (size_t)l * DB, P.a0 + (size_t)l * DB}; pg8::gemm_run(lds, g, S, E, tid);
        }
        GRID_BAR();
#ifdef DBG_CHECKS
        if (l == 0) { TIDS(); chk_lora(P, l, gw, ngw, lane); }
#endif
        { TIDS(); scan_phase(P, l, lds, tid); }
        GRID_BAR();
#ifdef DBG_CHECKS
        if (l == 0) { TIDS(); chk_scan(P, l, lds, gw, wid, lane); GRID_BAR(); }
#endif
        { TIDS(); p3b_phase(P, l, (size_t)blockIdx.x * 512 + tid, (size_t)G * 512); }
        if (l + 1 < DEPTH) { TIDS(); convert_win(P, l + 1, lds, gw, ngw, wid, lane); }
        GRID_BAR();
        {
            TIDS();
            pg8::StaticOrder S; S.init(NREAL, D, G, blockIdx.x);
            pg8::Gemm ga{(const bf16_t*)(P.ws + WS_CO), (const bf16_t*)(P.ws + WS_WA) + (size_t)l * D * DA, NREAL, D, DA};
            EpiY<false> Ea{hb, pbuf, PC_GA}; pg8::gemm_run(lds, ga, S, Ea, tid);
        }
        {
            TIDS();
            pg8::StaticOrder S; S.init(NREAL, D, G, blockIdx.x);
            pg8::Gemm gb{(const bf16_t*)(P.ws + WS_SB), (const bf16_t*)(P.ws + WS_WB) + (size_t)l * D * DB, NREAL, D, DB};
            EpiY<true> Eb{hb, pbuf, PC_GB}; pg8::gemm_run(lds, gb, S, Eb, tid);
        }
        { TIDS(); meta_p4(P, l, lds, wid, lane); }
        GRID_BAR();
#ifdef DBG_CHECKS
        if (l == 0) { TIDS(); chk_merged(P, l, gw, ngw, lane); }
#endif
        {
            TIDS();
            pg8::StaticOrder S; S.init(NREAL, D, G, blockIdx.x);
            pg8::Gemm g{hb, (const bf16_t*)(P.ws + WS_WO) + (size_t)l * D * D, NREAL, D, D};
            EpiOut E{(float*)(P.ws + WS_HF)}; pg8::gemm_run(lds, g, S, E, tid);
        }
        { TIDS(); meta_p5(P, l, lds, wid, lane); }
        GRID_BAR();
        { TIDS(); ln_phase(P, l, gw, ngw, lane); }
        if (l + 1 < DEPTH) GRID_BAR();
    }
#ifdef DBG_CHECKS
    GRID_BAR();
    { TIDS(); if (blockIdx.x == 0 && tid == 0) { const unsigned f = *(volatile unsigned*)(P.ws + WS_DBG); if (f) P.out[0] = 100.f * (float)(10 + f); } }
#endif
}

constexpr int LDS_BYTES = 131072 + 16;
extern "C" void kernel_launch(void* const* d_in, const int* in_sizes, int n_in, void* d_out, int out_size, void* d_ws, size_t ws_size, hipStream_t stream) {
    static int grid_blocks = 0;
    if (grid_blocks == 0) {
        if (n_in != 21 || ws_size < WS_BAR + 16384) { fprintf(stderr, "kernel_launch: unexpected n_in %d / ws_size %zu (need %zu)\n", n_in, ws_size, (size_t)WS_END); grid_blocks = -1; return; }
        int dev = 0, cus = 0, per_cu = 0;
        hipGetDevice(&dev); hipDeviceGetAttribute(&cus, hipDeviceAttributeMultiprocessorCount, dev);
        if (hipFuncSetAttribute((const void*)fwd_megakernel, hipFuncAttributeMaxDynamicSharedMemorySize, LDS_BYTES) != hipSuccess) fprintf(stderr, "kernel_launch: hipFuncSetAttribute failed\n");
        if (hipOccupancyMaxActiveBlocksPerMultiprocessor(&per_cu, (const void*)fwd_megakernel, 512, LDS_BYTES) != hipSuccess || per_cu < 1) { fprintf(stderr, "kernel_launch: occupancy query gave %d\n", per_cu); per_cu = 1; }
        (void)hipGetLastError();
        grid_blocks = cus * per_cu;
        if (grid_blocks > 256) grid_blocks = 256;
    }
    if (grid_blocks < 0) return;
    Params p{};
    const float** pp = (const float**)&p;
    for (int i = 0; i < 21; ++i) pp[i] = (const float*)d_in[i];
    p.out = (float*)d_out; p.ws = (unsigned char*)d_ws;
    void* args[] = {&p};
    hipError_t e = hipLaunchCooperativeKernel((const void*)fwd_megakernel, dim3(grid_blocks), dim3(512), args, LDS_BYTES, stream);
    if (e != hipSuccess) fprintf(stderr, "cooperative launch failed: %s (grid %d)\n", hipGetErrorString(e), grid_blocks);
}
```

```cpp
#include <hip/hip_runtime.h>
#include <hip/hip_cooperative_groups.h>
#include <cstdio>
#include <cstdint>
namespace cg = cooperative_groups;

#define LAS __attribute__((address_space(3)))
typedef unsigned short bf16_t;
typedef short bf16x8 __attribute__((ext_vector_type(8)));
typedef float f32x4 __attribute__((ext_vector_type(4)));
typedef float f32x2 __attribute__((ext_vector_type(2)));
typedef unsigned u32x4 __attribute__((ext_vector_type(4)));
typedef unsigned u32x2 __attribute__((ext_vector_type(2)));
typedef _Float16 h16x2 __attribute__((ext_vector_type(2)));

constexpr int D = 2048, SEQ = 16384, NBATCH = 2, DEPTH = 4;
constexpr int NREAL = NBATCH * SEQ;
constexpr int NMETA = 16;
constexpr int NROWS = NREAL + NMETA;
constexpr int MPAD = 33024;
constexpr int NCOLS = 16576, NP = 16640;
constexpr int DA = 1024, DB = 2048, NHEAD = 32, LORA = 96;
constexpr int PC_XIN = 0, PC_BG = 1024, PC_CG = 2048, PC_ZA = 3072, PC_R = 4096, PC_K = 6144, PC_V = 8192, PC_Z = 10240,
              PC_GA = 12288, PC_GB = 14336, PC_WLO = 16384, PC_ALO = 16480;
constexpr float LN_EPS = 1e-5f, GN_EPS = 6.4e-4f;
constexpr float ALPHA = 1.6817928305074292f;

constexpr size_t al256(size_t x) { return (x + 255) & ~(size_t)255; }
constexpr size_t WS_WIN = 0;
constexpr size_t WS_WA = al256(WS_WIN + (size_t)NP * D * 2);
constexpr size_t WS_WB = al256(WS_WA + (size_t)DEPTH * D * DA * 2);
constexpr size_t WS_WO = al256(WS_WB + (size_t)DEPTH * D * DB * 2);
constexpr size_t WS_WL = al256(WS_WO + (size_t)DEPTH * D * D * 2);
constexpr size_t WS_HF = al256(WS_WL + (size_t)DEPTH * 4096 * 256 * 2);
constexpr size_t WS_HB = al256(WS_HF + (size_t)MPAD * D * 4);
constexpr size_t WS_P = al256(WS_HB + (size_t)MPAD * D * 2);
constexpr size_t WS_CO = al256(WS_P + (size_t)MPAD * NP * 2);
constexpr size_t WS_SB = al256(WS_CO + (size_t)MPAD * DA * 2);
constexpr size_t WS_AB = al256(WS_SB + (size_t)MPAD * DB * 2);
constexpr size_t WS_AL = al256(WS_AB + (size_t)MPAD * DB * 2);
constexpr size_t WS_BON = al256(WS_AL + (size_t)MPAD * 256 * 2);
constexpr size_t WS_END = al256(WS_BON + (size_t)MPAD * 32 * 4);

struct Params {
    const float *x, *meta, *emb_g, *emb_b, *w_in, *conv_w, *w_a, *mu, *w0, *w2, *a0, *a2, *kks, *kas, *rk, *gn_g, *gn_b, *w_b, *w_out, *ln_g, *ln_b;
    float* out; unsigned char* ws;
};

__device__ __forceinline__ unsigned cvt_pk_bf16(float lo, float hi) { unsigned r; asm volatile("v_cvt_pk_bf16_f32 %0, %1, %2" : "=v"(r) : "v"(lo), "v"(hi)); return r; }
__device__ __forceinline__ float bf_lo(unsigned w) { return __uint_as_float(w << 16); }
__device__ __forceinline__ float bf_hi(unsigned w) { return __uint_as_float(w & 0xffff0000u); }
__device__ __forceinline__ void unpack8(const u32x4 w, float (&f)[8]) {
    f[0] = bf_lo(w.x); f[1] = bf_hi(w.x); f[2] = bf_lo(w.y); f[3] = bf_hi(w.y); f[4] = bf_lo(w.z); f[5] = bf_hi(w.z); f[6] = bf_lo(w.w); f[7] = bf_hi(w.w);
}
__device__ __forceinline__ u32x4 pack8(const float (&f)[8]) {
    u32x4 w; w.x = cvt_pk_bf16(f[0], f[1]); w.y = cvt_pk_bf16(f[2], f[3]); w.z = cvt_pk_bf16(f[4], f[5]); w.w = cvt_pk_bf16(f[6], f[7]); return w;
}
__device__ __forceinline__ unsigned pack_h2(float a, float b) { h16x2 v; v.x = (_Float16)a; v.y = (_Float16)b; return __builtin_bit_cast(unsigned, v); }
__device__ __forceinline__ float h_lo(unsigned w) { return (float)__builtin_bit_cast(_Float16, (unsigned short)(w & 0xffffu)); }
__device__ __forceinline__ float h_hi(unsigned w) { return (float)__builtin_bit_cast(_Float16, (unsigned short)(w >> 16)); }
__device__ __forceinline__ void unpack8h(const u32x4 w, float (&f)[8]) {
    f[0] = h_lo(w.x); f[1] = h_hi(w.x); f[2] = h_lo(w.y); f[3] = h_hi(w.y); f[4] = h_lo(w.z); f[5] = h_hi(w.z); f[6] = h_lo(w.w); f[7] = h_hi(w.w);
}
__device__ __forceinline__ float sigmoidf_(float v) { return __builtin_amdgcn_rcpf(1.0f + __expf(-v)); }
__device__ __forceinline__ float siluf_(float v) { return v * sigmoidf_(v); }
template <int CTRL> __device__ __forceinline__ float dpp_mov(float x) {
    return __builtin_bit_cast(float, __builtin_amdgcn_mov_dpp(__builtin_bit_cast(int, x), CTRL, 0xf, 0xf, true));
}
__device__ __forceinline__ float allred8(float x) { x += dpp_mov<0xB1>(x); x += dpp_mov<0x4E>(x); x += dpp_mov<0x141>(x); return x; }
__device__ __forceinline__ float allred16(float x) { x = allred8(x); x += dpp_mov<0x128>(x); return x; }
__device__ __forceinline__ float wave_sum(float v) {
#pragma unroll
    for (int o = 1; o < 64; o <<= 1) v += __shfl_xor(v, o);
    return v;
}
__device__ __forceinline__ int prev_row(int r) { if (r >= NREAL) return r == NREAL ? -1 : r - 1; return (r & (SEQ - 1)) ? r - 1 : NROWS - 1; }

#ifndef GEMM_SP2
#define GEMM_SP2 true
#endif
#ifndef GEMM_ALIGN
#define GEMM_ALIGN true
#endif
namespace pg8 {
constexpr int BM = 256, BK = 64, HALF = 128, HTB = HALF * BK * 2, STAGE_BYTES = 8 * HTB, NXCD = 8, WGM = 4;
__host__ __device__ __forceinline__ int lds_byte(int r, int c) { const int st = (r >> 4) * 2 + (c >> 5), rr = r & 15, cc = c & 31, ob = rr * 64 + cc * 2; return st * 1024 + (ob ^ (((ob >> 9) & 1) << 5)); }
__host__ __device__ __forceinline__ void stage_rc(int b, int& R, int& C) { const int st = b / 1024, sb = b % 1024, swz = sb ^ (((sb >> 9) & 1) << 5); R = (st >> 1) * 16 + swz / 64; C = (st & 1) * 32 + (swz % 64) / 2; }
__host__ __device__ __forceinline__ int perm32(int rho) { const int n = rho >> 4, i = rho & 15; return 8 * (i >> 2) + 4 * n + (i & 3); }
struct Unit { int pm, pn; };
struct Gemm { const bf16_t* A; const bf16_t* Bt; int M, N, K; };
struct StaticOrder {
    int nM, nN, nwg, G, c;
    __device__ void init(int M, int N, int G_, int c_) { nM = M / BM; nN = N / BM; nwg = nM * nN; G = G_; c = c_; }
    __device__ bool next(int i, Unit& u) const {
        const long L = (long)i * G + c; if (L >= nwg) return false;
        int wgid = (int)L; { const int q = nwg / NXCD, r = nwg % NXCD, xcd = wgid % NXCD, off = wgid / NXCD; wgid = (xcd < r ? xcd * (q + 1) : r * (q + 1) + (xcd - r) * q) + off; }
        const int nig = WGM * nN, gid = wgid / nig, fm = gid * WGM, gsz = (nM - fm) < WGM ? (nM - fm) : WGM;
        u.pm = fm + ((wgid % nig) % gsz); u.pn = (wgid % nig) / gsz; return true;
    }
    __device__ __forceinline__ void a_ready(const Unit&) const {}
    __device__ __forceinline__ void done(const Unit&) const {}
};

template <class Epi, class Sched, bool ALIGN_EPI = false, bool SP2 = false>
__device__ __forceinline__ void gemm_phase(LAS unsigned char* lds, const Gemm g, const Sched& S, const Epi& E, const int tid) {
    const int wid = __builtin_amdgcn_readfirstlane(tid >> 6), lane = tid & 63, wr = wid >> 2, wc = wid & 3, fr = lane & 15, fq = lane >> 4;
    int K = g.K; asm volatile("" : "+s"(K)); const int nt = K / BK;
    unsigned voffA[2], voffB[2];
#pragma unroll
    for (int i = 0; i < 2; ++i) { int R, C; stage_rc(tid * 16 + i * 8192, R, C); const int Rb = Epi::PERM ? ((R & ~31) + perm32(R & 31)) : R;
        voffA[i] = (unsigned)(R * K + C) * 2u; voffB[i] = (unsigned)(Rb * K + C) * 2u; }
    const size_t kstep = (size_t)(BK * 2);
    const size_t hstep = (size_t)HALF * K * 2;
    const size_t tstep = 2 * hstep;
    const unsigned ldsw = (unsigned)wid * 1024u;
    const int aoff = lds_byte(wr * 64 + fr, fq * 8), boff = lds_byte(wc * 32 + fr, fq * 8);
#define PG8_SA(b, h) (((b) * 2 + (h)) * HTB)
#define PG8_SB(b, h) ((4 + (b) * 2 + (h)) * HTB)
#define PG8_STAGE(bufoff, gbase, voff) do { _Pragma("unroll") for (int _i = 0; _i < 2; ++_i) \
        __builtin_amdgcn_global_load_lds((const unsigned*)((const char*)(gbase) + (voff)[_i]), (LAS unsigned*)(lds + (bufoff) + ldsw + _i * 8192), 16, 0, 0); } while (0)
#define PG8_LDA(dst, b, h) do { _Pragma("unroll") for (int m = 0; m < 4; ++m) _Pragma("unroll") for (int k = 0; k < 2; ++k) dst[m][k] = *(const LAS bf16x8*)(lds + PG8_SA(b, h) + aoff + m * 2048 + k * 1024); } while (0)
#define PG8_LDB(dst, b, h) do { _Pragma("unroll") for (int n = 0; n < 2; ++n) _Pragma("unroll") for (int k = 0; k < 2; ++k) dst[n][k] = *(const LAS bf16x8*)(lds + PG8_SB(b, h) + boff + n * 2048 + k * 1024); } while (0)
#define PG8_MMA(ai, bj, At, Bt) do { __builtin_amdgcn_s_setprio(1); _Pragma("unroll") for (int m = 0; m < 4; ++m) _Pragma("unroll") for (int n = 0; n < 2; ++n) _Pragma("unroll") for (int k = 0; k < 2; ++k) \
        acc[ai][bj][m][n] = __builtin_amdgcn_mfma_f32_16x16x32_bf16(Bt[n][k], At[m][k], acc[ai][bj][m][n], 0, 0, 0); __builtin_amdgcn_s_setprio(0); } while (0)
#define PG8_WAIT_V(n) asm volatile("s_waitcnt vmcnt(" #n ")" ::: "memory")
#define PG8_WAIT_L(n) asm volatile("s_waitcnt lgkmcnt(" #n ")" ::: "memory")
#define PG8_BAR __builtin_amdgcn_s_barrier()
#define PG8_SCHED __builtin_amdgcn_sched_barrier(0)
    Unit cur, nxt; int ui = 0;
    if (!S.next(0, cur)) return;
    f32x4 acc[2][2][4][2];
#pragma unroll
    for (int a = 0; a < 2; ++a)
#pragma unroll
        for (int b = 0; b < 2; ++b)
#pragma unroll
            for (int m = 0; m < 4; ++m)
#pragma unroll
                for (int n = 0; n < 2; ++n) acc[a][b][m][n] = (f32x4){0.f, 0.f, 0.f, 0.f};
    bf16x8 At[4][2], B0[2][2], B1[2][2];
    const char* cA = (const char*)g.A + (size_t)cur.pm * tstep; const char* cB = (const char*)g.Bt + (size_t)cur.pn * tstep;
    S.a_ready(cur);
    if constexpr (SP2) {
        PG8_STAGE(PG8_SB(0, 0), cB, voffB); PG8_STAGE(PG8_SB(0, 1), cB + hstep, voffB); PG8_STAGE(PG8_SA(0, 0), cA, voffA); PG8_STAGE(PG8_SA(0, 1), cA + hstep, voffA);
        if (wr == 1) PG8_BAR;
        PG8_WAIT_V(2); PG8_BAR;
        PG8_STAGE(PG8_SB(1, 0), cB + kstep, voffB); PG8_STAGE(PG8_SA(1, 0), cA + kstep, voffA); PG8_STAGE(PG8_SB(1, 1), cB + hstep + kstep, voffB);
        PG8_WAIT_V(6); PG8_BAR;
    } else {
        PG8_STAGE(PG8_SB(0, 0), cB, voffB); PG8_STAGE(PG8_SA(0, 0), cA, voffA); PG8_STAGE(PG8_SB(0, 1), cB + hstep, voffB); PG8_STAGE(PG8_SA(0, 1), cA + hstep, voffA);
        if (wr == 1) PG8_BAR;
        PG8_WAIT_V(4); PG8_BAR;
        PG8_STAGE(PG8_SB(1, 0), cB + kstep, voffB); PG8_STAGE(PG8_SA(1, 0), cA + kstep, voffA); PG8_STAGE(PG8_SB(1, 1), cB + hstep + kstep, voffB);
        PG8_WAIT_V(6); PG8_BAR;
    }
    for (;;) {
        const bool has_next = S.next(ui + 1, nxt);
        const char* nA = has_next ? (const char*)g.A + (size_t)nxt.pm * tstep : cA; const char* nB = has_next ? (const char*)g.Bt + (size_t)nxt.pn * tstep : cB;
        for (int t = 0; t < nt; t += 2) {
            const bool last = (t == nt - 2);
            const char* a1 = cA + (size_t)(t + 1) * kstep;
            const char* a2 = last ? nA : cA + (size_t)(t + 2) * kstep; const char* b2 = last ? nB : cB + (size_t)(t + 2) * kstep;
            const char* a3 = a2 + kstep; const char* b3 = b2 + kstep;
            if (last && has_next) S.a_ready(nxt);
            if constexpr (SP2) {
            PG8_LDB(B0, 0, 0); PG8_LDB(B1, 0, 1); PG8_SCHED; PG8_LDA(At, 0, 0); PG8_STAGE(PG8_SA(1, 1), a1 + hstep, voffA);
            PG8_WAIT_V(8); PG8_WAIT_L(0); PG8_BAR; PG8_MMA(0, 0, At, B0); PG8_MMA(0, 1, At, B1); PG8_BAR; PG8_SCHED;
            PG8_LDA(At, 0, 1); PG8_STAGE(PG8_SB(0, 0), b2, voffB); PG8_STAGE(PG8_SB(0, 1), b2 + hstep, voffB); PG8_STAGE(PG8_SA(0, 0), a2, voffA);
            PG8_WAIT_V(8); PG8_WAIT_L(0); PG8_BAR; PG8_MMA(1, 0, At, B0); PG8_MMA(1, 1, At, B1); PG8_BAR; PG8_SCHED;
            PG8_LDB(B0, 1, 0); PG8_LDB(B1, 1, 1); PG8_SCHED; PG8_LDA(At, 1, 0); PG8_STAGE(PG8_SA(0, 1), a2 + hstep, voffA);
            PG8_WAIT_V(8); PG8_WAIT_L(0); PG8_BAR; PG8_MMA(0, 0, At, B0); PG8_MMA(0, 1, At, B1); PG8_BAR; PG8_SCHED;
            PG8_LDA(At, 1, 1); PG8_STAGE(PG8_SB(1, 0), b3, voffB); PG8_STAGE(PG8_SB(1, 1), b3 + hstep, voffB); PG8_STAGE(PG8_SA(1, 0), a3, voffA);
            PG8_WAIT_V(8); PG8_WAIT_L(0); PG8_BAR; PG8_MMA(1, 0, At, B0); PG8_MMA(1, 1, At, B1); PG8_BAR; PG8_SCHED;
            } else {
            PG8_LDB(B0, 0, 0); PG8_SCHED; PG8_LDA(At, 0, 0); PG8_STAGE(PG8_SA(1, 1), a1 + hstep, voffA);
            PG8_WAIT_L(8); PG8_BAR; PG8_WAIT_L(0); PG8_MMA(0, 0, At, B0); PG8_BAR; PG8_SCHED;
            PG8_LDB(B1, 0, 1); PG8_STAGE(PG8_SB(0, 0), b2, voffB);
            PG8_BAR; PG8_WAIT_L(0); PG8_MMA(0, 1, At, B1); PG8_BAR;
            PG8_LDA(At, 0, 1); PG8_STAGE(PG8_SA(0, 0), a2, voffA);
            PG8_BAR; PG8_WAIT_L(0); PG8_MMA(1, 0, At, B0); PG8_BAR; PG8_SCHED;
            PG8_STAGE(PG8_SB(0, 1), b2 + hstep, voffB);
            PG8_WAIT_V(6); PG8_BAR; PG8_MMA(1, 1, At, B1); PG8_BAR;
            PG8_LDB(B0, 1, 0); PG8_SCHED; PG8_LDA(At, 1, 0); PG8_STAGE(PG8_SA(0, 1), a2 + hstep, voffA);
            PG8_WAIT_L(8); PG8_BAR; PG8_WAIT_L(0); PG8_MMA(0, 0, At, B0); PG8_BAR; PG8_SCHED;
            PG8_LDB(B1, 1, 1); PG8_STAGE(PG8_SB(1, 0), b3, voffB);
            PG8_BAR; PG8_WAIT_L(0); PG8_MMA(0, 1, At, B1); PG8_BAR;
            PG8_LDA(At, 1, 1); PG8_STAGE(PG8_SA(1, 0), a3, voffA);
            PG8_BAR; PG8_WAIT_L(0); PG8_MMA(1, 0, At, B0); PG8_BAR; PG8_SCHED;
            PG8_STAGE(PG8_SB(1, 1), b3 + hstep, voffB);
            PG8_WAIT_V(6); PG8_BAR; PG8_MMA(1, 1, At, B1); PG8_BAR;
            }
        }
        if constexpr (ALIGN_EPI) { if (wr == 0) PG8_BAR; }
        E(acc, cur, wr, wc, fr, fq); S.done(cur);
        if (!has_next) break;
#pragma unroll
        for (int a = 0; a < 2; ++a)
#pragma unroll
            for (int b = 0; b < 2; ++b)
#pragma unroll
                for (int m = 0; m < 4; ++m)
#pragma unroll
                    for (int n = 0; n < 2; ++n) acc[a][b][m][n] = (f32x4){0.f, 0.f, 0.f, 0.f};
        cur = nxt; cA = nA; cB = nB; ++ui;
        if constexpr (ALIGN_EPI) { if (wr == 1) PG8_BAR; }
    }
    PG8_WAIT_V(0);
    if constexpr (!ALIGN_EPI) { if (wr == 0) PG8_BAR; }
    PG8_BAR;
#undef PG8_SA
#undef PG8_SB
#undef PG8_STAGE
#undef PG8_LDA
#undef PG8_LDB
#undef PG8_MMA
#undef PG8_WAIT_V
#undef PG8_WAIT_L
#undef PG8_BAR
#undef PG8_SCHED
}
template <class Epi>
__device__ __forceinline__ void gemm_run(LAS unsigned char* lds, const Gemm g, const StaticOrder& S, const Epi& E, const int tid) { gemm_phase<Epi, StaticOrder, GEMM_ALIGN, GEMM_SP2>(lds, g, S, E, tid); }
}

struct EpiP {
    static constexpr bool PERM = true;
    bf16_t* O;
    __device__ __forceinline__ void operator()(const f32x4 (&acc)[2][2][4][2], const pg8::Unit& u, int wr, int wc, int fr, int fq) const {
        const int row0 = u.pm * 256 + wr * 64 + fr, col0 = u.pn * 256 + wc * 32 + 8 * fq;
#pragma unroll
        for (int ai = 0; ai < 2; ++ai)
#pragma unroll
            for (int m = 0; m < 4; ++m) { bf16_t* rowp = O + (size_t)(row0 + ai * 128 + m * 16) * NP + col0;
#pragma unroll
                for (int bj = 0; bj < 2; ++bj) { const f32x4 v0 = acc[ai][bj][m][0], v1 = acc[ai][bj][m][1];
                    u32x4 w; w.x = cvt_pk_bf16(v0[0], v0[1]); w.y = cvt_pk_bf16(v0[2], v0[3]); w.z = cvt_pk_bf16(v1[0], v1[1]); w.w = cvt_pk_bf16(v1[2], v1[3]);
                    *(u32x4*)(rowp + bj * 128) = w; } }
    }
};
struct EpiLora {
    static constexpr bool PERM = true;
    unsigned short *X, *Ab; const float *w0, *a0;
    __device__ __forceinline__ void operator()(const f32x4 (&acc)[2][2][4][2], const pg8::Unit& u, int wr, int wc, int fr, int fq) const {
        const int row0 = u.pm * 256 + wr * 64 + fr; const int colt = u.pn * 256; const bool isA = colt >= 2048;
        unsigned short* base = isA ? Ab : X; const float* bias = isA ? a0 : w0; const float scale = isA ? 1.0f : 0.60653065971f;
        const int cc = (colt & 2047) + wc * 32 + 8 * fq;
        f32x4 bv[2][2];
#pragma unroll
        for (int bj = 0; bj < 2; ++bj) { bv[bj][0] = *(const f32x4*)(bias + cc + bj * 128); bv[bj][1] = *(const f32x4*)(bias + cc + bj * 128 + 4); }
#pragma unroll
        for (int ai = 0; ai < 2; ++ai)
#pragma unroll
            for (int m = 0; m < 4; ++m) { unsigned short* rowp = base + (size_t)(row0 + ai * 128 + m * 16) * DB + cc;
#pragma unroll
                for (int bj = 0; bj < 2; ++bj) { const f32x4 v0 = acc[ai][bj][m][0] + bv[bj][0], v1 = acc[ai][bj][m][1] + bv[bj][1];
                    u32x4 w; w.x = pack_h2(scale * sigmoidf_(v0[0]), scale * sigmoidf_(v0[1])); w.y = pack_h2(scale * sigmoidf_(v0[2]), scale * sigmoidf_(v0[3]));
                    w.z = pack_h2(scale * sigmoidf_(v1[0]), scale * sigmoidf_(v1[1])); w.w = pack_h2(scale * sigmoidf_(v1[2]), scale * sigmoidf_(v1[3]));
                    *(u32x4*)(rowp + bj * 128) = w; } }
    }
};
template <bool ACCUM> struct EpiY {
    static constexpr bool PERM = true;
    bf16_t* Mg; const bf16_t* P; int gcol;
    __device__ __forceinline__ void operator()(const f32x4 (&acc)[2][2][4][2], const pg8::Unit& u, int wr, int wc, int fr, int fq) const {
        const int row0 = u.pm * 256 + wr * 64 + fr, col0 = u.pn * 256 + wc * 32 + 8 * fq;
#pragma unroll
        for (int ai = 0; ai < 2; ++ai)
#pragma unroll
            for (int m = 0; m < 4; ++m) { const int row = row0 + ai * 128 + m * 16;
#pragma unroll
                for (int bj = 0; bj < 2; ++bj) { const int col = col0 + bj * 128;
                    const u32x4 gw = *(const u32x4*)(P + (size_t)row * NP + gcol + col);
                    float g[8], o[8]; unpack8(gw, g);
                    const f32x4 v0 = acc[ai][bj][m][0], v1 = acc[ai][bj][m][1];
#pragma unroll
                    for (int e = 0; e < 4; ++e) { o[e] = sigmoidf_(g[e]) * v0[e]; o[4 + e] = sigmoidf_(g[4 + e]) * v1[e]; }
                    bf16_t* dst = Mg + (size_t)row * D + col;
                    if (ACCUM) { const u32x4 ow = *(const u32x4*)dst; float od[8]; unpack8(ow, od);
#pragma unroll
                        for (int e = 0; e < 8; ++e) o[e] += od[e]; }
                    *(u32x4*)dst = pack8(o); } }
    }
};
struct EpiOut {
    static constexpr bool PERM = false;
    float* H;
    __device__ __forceinline__ void operator()(const f32x4 (&acc)[2][2][4][2], const pg8::Unit& u, int wr, int wc, int fr, int fq) const {
        const int row0 = u.pm * 256 + wr * 64 + fr, col0 = u.pn * 256 + wc * 32 + 4 * fq;
#pragma unroll
        for (int ai = 0; ai < 2; ++ai)
#pragma unroll
            for (int m = 0; m < 4; ++m) { float* rowp = H + (size_t)(row0 + ai * 128 + m * 16) * D + col0;
#pragma unroll
                for (int bj = 0; bj < 2; ++bj)
#pragma unroll
                    for (int n = 0; n < 2; ++n) { f32x4* ptr = (f32x4*)(rowp + bj * 128 + n * 16); *ptr = ALPHA * (*ptr) + acc[ai][bj][m][n]; } }
    }
};


template <int KS  >
__device__ __forceinline__ f32x4 meta_dot(const bf16_t* A  , const bf16_t* Bt  , int K, int ct, int k0, int fr, int fq) {
    f32x4 acc = (f32x4){0.f, 0.f, 0.f, 0.f};
    const bf16_t* ap = A + (size_t)fr * K + k0 + fq * 8; const bf16_t* bp = Bt + (size_t)(ct * 16 + fr) * K + k0 + fq * 8;
    bf16x8 a[KS / 32], b[KS / 32];
#pragma unroll
    for (int i = 0; i < KS / 32; ++i) { a[i] = *(const bf16x8*)(ap + i * 32); b[i] = *(const bf16x8*)(bp + i * 32); }
#pragma unroll
    for (int i = 0; i < KS / 32; ++i) acc = __builtin_amdgcn_mfma_f32_16x16x32_bf16(b[i], a[i], acc, 0, 0, 0);
    return acc;
}
__device__ __forceinline__ void meta_p4(const Params& P, int l, LAS unsigned char* lds, int wid, int lane) {
    if (blockIdx.x >= D / 16) return;
    const int ct = blockIdx.x, fr = lane & 15, fq = lane >> 4;
    const f32x4 ya = meta_dot<DA / 8>((const bf16_t*)(P.ws + WS_CO) + (size_t)NREAL * DA, (const bf16_t*)(P.ws + WS_WA) + (size_t)l * D * DA, DA, ct, wid * (DA / 8), fr, fq);
    const f32x4 yb = meta_dot<DB / 8>((const bf16_t*)(P.ws + WS_SB) + (size_t)NREAL * DB, (const bf16_t*)(P.ws + WS_WB) + (size_t)l * D * DB, DB, ct, wid * (DB / 8), fr, fq);
    LAS f32x4* red = (LAS f32x4*)lds;
    red[(wid * 2 + 0) * 64 + lane] = ya; red[(wid * 2 + 1) * 64 + lane] = yb;
    __syncthreads();
    if (wid == 0) {
        f32x4 sa = red[lane], sb2 = red[64 + lane];
#pragma unroll
        for (int w = 1; w < 8; ++w) { sa += red[(w * 2) * 64 + lane]; sb2 += red[(w * 2 + 1) * 64 + lane]; }
        const int row = NREAL + fr, c0 = ct * 16 + 4 * fq;
        const bf16_t* pr = (const bf16_t*)(P.ws + WS_P) + (size_t)row * NP;
        const u32x2 ga = *(const u32x2*)(pr + PC_GA + c0), gb = *(const u32x2*)(pr + PC_GB + c0);
        const float o0 = sigmoidf_(bf_lo(ga.x)) * sa[0] + sigmoidf_(bf_lo(gb.x)) * sb2[0], o1 = sigmoidf_(bf_hi(ga.x)) * sa[1] + sigmoidf_(bf_hi(gb.x)) * sb2[1];
        const float o2 = sigmoidf_(bf_lo(ga.y)) * sa[2] + sigmoidf_(bf_lo(gb.y)) * sb2[2], o3 = sigmoidf_(bf_hi(ga.y)) * sa[3] + sigmoidf_(bf_hi(gb.y)) * sb2[3];
        u32x2 w; w.x = cvt_pk_bf16(o0, o1); w.y = cvt_pk_bf16(o2, o3);
        *(u32x2*)((bf16_t*)(P.ws + WS_HB) + (size_t)row * D + c0) = w;
    }
}
__device__ __forceinline__ void meta_p5(const Params& P, int l, LAS unsigned char* lds, int wid, int lane) {
    if (blockIdx.x >= D / 16) return;
    const int ct = blockIdx.x, fr = lane & 15, fq = lane >> 4;
    const f32x4 acc = meta_dot<D / 8>((const bf16_t*)(P.ws + WS_HB) + (size_t)NREAL * D, (const bf16_t*)(P.ws + WS_WO) + (size_t)l * D * D, D, ct, wid * (D / 8), fr, fq);
    LAS f32x4* red = (LAS f32x4*)lds;
    red[wid * 64 + lane] = acc;
    __syncthreads();
    if (wid == 0) {
        f32x4 sa = red[lane];
#pragma unroll
        for (int w = 1; w < 8; ++w) sa += red[w * 64 + lane];
        f32x4* ptr = (f32x4*)((float*)(P.ws + WS_HF) + (size_t)(NREAL + fr) * D + ct * 16 + 4 * fq);
        *ptr = ALPHA * (*ptr) + sa;
    }
}

__device__ __forceinline__ void transpose_item(const float* W, int ldw, int src_n0, int k0, bf16_t* WT, int K, int dst_n0, LAS float* scr, int lane) {
    if (src_n0 >= 0) {
        f32x4 v[8]; const int n4 = (lane & 7) * 4;
#pragma unroll
        for (int i = 0; i < 8; ++i) v[i] = *(const f32x4*)(W + (size_t)(k0 + (lane >> 3) + 8 * i) * ldw + src_n0 + n4);
#pragma unroll
        for (int i = 0; i < 8; ++i) { LAS float* d = scr + ((lane >> 3) + 8 * i) * 33 + n4; d[0] = v[i].x; d[1] = v[i].y; d[2] = v[i].z; d[3] = v[i].w; }
    }
    asm volatile("s_waitcnt lgkmcnt(0)" ::: "memory");
    const int c = lane & 7;
#pragma unroll
    for (int j = 0; j < 4; ++j) { const int n = (lane >> 3) + 8 * j; const LAS float* s = scr + (8 * c) * 33 + n;
        u32x4 o = (u32x4){0u, 0u, 0u, 0u};
        if (src_n0 >= 0) { o.x = cvt_pk_bf16(s[0 * 33], s[1 * 33]); o.y = cvt_pk_bf16(s[2 * 33], s[3 * 33]); o.z = cvt_pk_bf16(s[4 * 33], s[5 * 33]); o.w = cvt_pk_bf16(s[6 * 33], s[7 * 33]); }
        *(u32x4*)(WT + (size_t)(dst_n0 + n) * K + k0 + 8 * c) = o; }
    asm volatile("s_waitcnt lgkmcnt(0)" ::: "memory");
}
__device__ __forceinline__ int win_src_col(int j) { return j < 12288 ? j : (j < 16384 ? j + 192 : (j < 16576 ? j - 4096 : -1)); }

__device__ __forceinline__ void convert_win(const Params& P, int l, LAS unsigned char* lds, int gw, int ngw, int wid, int lane) {
    LAS float* scr = (LAS float*)(lds + wid * 8448);
    const float* W = P.w_in + (size_t)l * D * NCOLS; bf16_t* WT = (bf16_t*)(P.ws + WS_WIN);
    constexpr int NBLK = NP / 32;
    for (int it = gw; it < (D / 64) * NBLK; it += ngw) { const int kb = it / NBLK, nb = it % NBLK;
        transpose_item(W, NCOLS, win_src_col(nb * 32), kb * 64, WT, D, nb * 32, scr, lane); }
}
__device__ __forceinline__ void convert_small(const Params& P, LAS unsigned char* lds, int gw, int ngw, int wid, int lane) {
    LAS float* scr = (LAS float*)(lds + wid * 8448);
    constexpr int IA = (DA / 64) * (D / 32), IB = (DB / 64) * (D / 32), IO = (D / 64) * (D / 32), IL = IA + IB + IO;
    for (int it = gw; it < DEPTH * IL; it += ngw) { const int l = it / IL; int r = it % IL;
        if (r < IA) { transpose_item(P.w_a + (size_t)l * DA * D, D, (r % (D / 32)) * 32, (r / (D / 32)) * 64, (bf16_t*)(P.ws + WS_WA) + (size_t)l * D * DA, DA, (r % (D / 32)) * 32, scr, lane); continue; } r -= IA;
        if (r < IB) { transpose_item(P.w_b + (size_t)l * DB * D, D, (r % (D / 32)) * 32, (r / (D / 32)) * 64, (bf16_t*)(P.ws + WS_WB) + (size_t)l * D * DB, DB, (r % (D / 32)) * 32, scr, lane); continue; } r -= IB;
        transpose_item(P.w_out + (size_t)l * D * D, D, (r % (D / 32)) * 32, (r / (D / 32)) * 64, (bf16_t*)(P.ws + WS_WO) + (size_t)l * D * D, D, (r % (D / 32)) * 32, scr, lane); }
    bf16_t* WL = (bf16_t*)(P.ws + WS_WL);
    const size_t tot = (size_t)DEPTH * 4096 * 32;
    for (size_t it = (size_t)gw * 64 + lane; it < tot; it += (size_t)ngw * 64) {
        const int n = (int)(it % 4096); const int kc = (int)((it / 4096) % 32) * 8; const int l = (int)(it / (4096 * 32));
        float f[8];
#pragma unroll
        for (int e = 0; e < 8; ++e) { const int k = kc + e; float v = 0.f;
            if (n < 2048) { if (k < LORA) v = P.w2[((size_t)l * LORA + k) * DB + n]; }
            else { if (k >= 128 && k < 128 + LORA) v = P.a2[((size_t)l * LORA + (k - 128)) * DB + (n - 2048)]; }
            f[e] = v; }
        *(u32x4*)(WL + ((size_t)l * 4096 + n) * 256 + kc) = pack8(f);
    }
}
__device__ __forceinline__ void ln_row(const float* src, const float* g, const float* b, float* dstf, bf16_t* dstb, int lane) {
    const f32x4* xr = (const f32x4*)src + lane;
    f32x4 v[8]; float s = 0.f;
#pragma unroll
    for (int j = 0; j < 8; ++j) { v[j] = xr[64 * j]; s += (v[j].x + v[j].y) + (v[j].z + v[j].w); }
    const float mean = wave_sum(s) * (1.f / D); float s2 = 0.f;
#pragma unroll
    for (int j = 0; j < 8; ++j) { v[j] = v[j] - mean; s2 += (v[j].x * v[j].x + v[j].y * v[j].y) + (v[j].z * v[j].z + v[j].w * v[j].w); }
    const float rstd = 1.f / sqrtf(wave_sum(s2) * (1.f / D) + LN_EPS);
#pragma unroll
    for (int j = 0; j < 8; ++j) { const f32x4 gg = ((const f32x4*)g)[lane + 64 * j], bb = ((const f32x4*)b)[lane + 64 * j];
        const f32x4 o = v[j] * rstd * gg + bb;
        if (dstf) ((f32x4*)dstf)[lane + 64 * j] = o;
        if (dstb) { u32x2 w; w.x = cvt_pk_bf16(o.x, o.y); w.y = cvt_pk_bf16(o.z, o.w); ((u32x2*)dstb)[lane + 64 * j] = w; } }
}
__device__ __forceinline__ void embed_phase(const Params& P, int gw, int ngw, int lane) {
    float* hf = (float*)(P.ws + WS_HF); bf16_t* hb = (bf16_t*)(P.ws + WS_HB);
    for (int r = gw; r < MPAD; r += ngw) {
        if (r < NROWS) { const float* src = r < NREAL ? P.x + (size_t)r * D : P.meta + (size_t)(r - NREAL) * D;
            ln_row(src, P.emb_g, P.emb_b, hf + (size_t)r * D, hb + (size_t)r * D, lane); }
        else {
#pragma unroll
            for (int j = 0; j < 8; ++j) { ((f32x4*)(hf + (size_t)r * D))[lane + 64 * j] = (f32x4){0.f, 0.f, 0.f, 0.f}; ((u32x2*)(hb + (size_t)r * D))[lane + 64 * j] = (u32x2){0u, 0u}; }
        }
    }
}
__device__ __forceinline__ void ln_phase(const Params& P, int l, int gw, int ngw, int lane) {
    float* hf = (float*)(P.ws + WS_HF); bf16_t* hb = (bf16_t*)(P.ws + WS_HB);
    const float* g = P.ln_g + (size_t)l * D; const float* b = P.ln_b + (size_t)l * D;
    if (l == DEPTH - 1) { for (int r = gw; r < NREAL; r += ngw) ln_row(hf + (size_t)r * D, g, b, P.out + (size_t)r * D, nullptr, lane); }
    else { for (int r = gw; r < NROWS; r += ngw) ln_row(hf + (size_t)r * D, g, b, hf + (size_t)r * D, hb + (size_t)r * D, lane); }
}

constexpr int RUN = 8, NRUN = NROWS / RUN;
__device__ __forceinline__ void p2_phase(const Params& P, int l, size_t gtid, size_t gthreads) {
    const bf16_t* p = (const bf16_t*)(P.ws + WS_P); bf16_t* co = (bf16_t*)(P.ws + WS_CO); bf16_t* al = (bf16_t*)(P.ws + WS_AL);
    const float* cw = P.conv_w + (size_t)l * 3 * DA; const float* mu = P.mu + (size_t)l * 8384;
    const size_t tot = (size_t)NRUN * 160;
    for (size_t it = gtid; it < tot; it += gthreads) {
        const int run = (int)(it / 160), ch = (int)(it % 160); const int row0 = run * RUN;
        const int r1 = prev_row(row0), r2 = r1 >= 0 ? prev_row(r1) : -1;
        if (ch < 128) {
            const int c0 = ch * 8;
            float w0[8], w1[8], w2[8], u1[8], u2[8], xa[8], xb[8];
#pragma unroll
            for (int e = 0; e < 8; ++e) { w0[e] = cw[c0 + e]; w1[e] = cw[DA + c0 + e]; w2[e] = cw[2 * DA + c0 + e]; u1[e] = 0.f; u2[e] = 0.f; }
            if (r1 >= 0) { const bf16_t* q = p + (size_t)r1 * NP; unpack8(*(const u32x4*)(q + PC_XIN + c0), xa); unpack8(*(const u32x4*)(q + PC_CG + c0), xb);
#pragma unroll
                for (int e = 0; e < 8; ++e) u1[e] = xa[e] * xb[e]; }
            if (r2 >= 0) { const bf16_t* q = p + (size_t)r2 * NP; unpack8(*(const u32x4*)(q + PC_XIN + c0), xa); unpack8(*(const u32x4*)(q + PC_CG + c0), xb);
#pragma unroll
                for (int e = 0; e < 8; ++e) u2[e] = xa[e] * xb[e]; }
            u32x4 Lx[RUN], Lc[RUN], Lb[RUN], Lz[RUN];
#pragma unroll
            for (int rr = 0; rr < RUN; ++rr) { const bf16_t* pr = p + (size_t)(row0 + rr) * NP + c0; Lx[rr] = *(const u32x4*)(pr + PC_XIN); Lc[rr] = *(const u32x4*)(pr + PC_CG); Lb[rr] = *(const u32x4*)(pr + PC_BG); Lz[rr] = *(const u32x4*)(pr + PC_ZA); }
#pragma unroll
            for (int rr = 0; rr < RUN; ++rr) {
                float bg[8], z[8], o[8], u0[8]; unpack8(Lx[rr], xa); unpack8(Lc[rr], xb); unpack8(Lb[rr], bg); unpack8(Lz[rr], z);
#pragma unroll
                for (int e = 0; e < 8; ++e) { u0[e] = xa[e] * xb[e]; const float cv = w0[e] * u2[e] + w1[e] * u1[e] + w2[e] * u0[e]; o[e] = bg[e] * cv * siluf_(z[e]); u2[e] = u1[e]; u1[e] = u0[e]; }
                *(u32x4*)(co + (size_t)(row0 + rr) * DA + c0) = pack8(o);
            }
        } else {
            const int kc = (ch - 128) * 8;
            const bool isw = kc < LORA, isa = (kc >= 128 && kc < 128 + LORA);
            if (isw || isa) {
                const int pc = isw ? PC_WLO + kc : PC_ALO + (kc - 128); const int mi = isw ? 8192 + kc : 8288 + (kc - 128);
                float m[8], q[8], c[8], o[8];
#pragma unroll
                for (int e = 0; e < 8; ++e) { m[e] = mu[mi + e]; q[e] = 0.f; }
                if (r1 >= 0) unpack8(*(const u32x4*)(p + (size_t)r1 * NP + pc), q);
                u32x4 Lc[RUN];
#pragma unroll
                for (int rr = 0; rr < RUN; ++rr) Lc[rr] = *(const u32x4*)(p + (size_t)(row0 + rr) * NP + pc);
#pragma unroll
                for (int rr = 0; rr < RUN; ++rr) { unpack8(Lc[rr], c);
#pragma unroll
                    for (int e = 0; e < 8; ++e) { const float v = c[e] + m[e] * (q[e] - c[e]); o[e] = isw ? tanhf(v) : v; q[e] = c[e]; }
                    *(u32x4*)(al + (size_t)(row0 + rr) * 256 + kc) = pack8(o); }
            } else {
#pragma unroll
                for (int rr = 0; rr < RUN; ++rr) *(u32x4*)(al + (size_t)(row0 + rr) * 256 + kc) = (u32x4){0u, 0u, 0u, 0u};
            }
        }
    }
}

constexpr int TC = 32, NCH = 1 + SEQ / TC;
constexpr int REC = 1280;
constexpr int SC_OPND = 0, SC_V = TC * REC, SC_Y = SC_V + TC * 16 * 8, SC_BUF = SC_Y + TC * 16 * 4;
#define SCAN_BARRIER() do { asm volatile("s_waitcnt lgkmcnt(0)" ::: "memory"); __builtin_amdgcn_s_barrier(); asm volatile("" ::: "memory"); } while (0)
__device__ __forceinline__ void scan_phase(const Params& P, int l, LAS unsigned char* lds, const int tid) {
    const int wid = __builtin_amdgcn_readfirstlane(tid >> 6), lane = tid & 63;
    const bf16_t* p = (const bf16_t*)(P.ws + WS_P); const unsigned short* xb = (const unsigned short*)(P.ws + WS_HB); const unsigned short* ab = (const unsigned short*)(P.ws + WS_AB);
    bf16_t* sb = (bf16_t*)(P.ws + WS_SB); float* bon = (float*)(P.ws + WS_BON);
    for (int item = blockIdx.x; item < 256; item += gridDim.x) {
        const int xcd_ = item & 7, y_ = item >> 3, hh_ = xcd_ * 8 + (y_ >> 2);
        const int b = hh_ >> 5, h = hh_ & 31, q = y_ & 3;
        const int j = tid & 255, tt = j >> 3, cgp = j & 7, c0 = h * 64 + cgp * 8;
        const bool vown = (cgp >> 1) == q;
        u32x4 LAr0, LAr1, LAk0, LAk1, LAx, LAa, LBr0, LBr1, LBk0, LBk1, LBx, LBa; unsigned LAv0 = 0u, LAv1 = 0u, LBv0 = 0u, LBv1 = 0u;
        LAr0 = LAr1 = LAk0 = LAk1 = LAx = LAa = LBr0 = LBr1 = LBk0 = LBk1 = LBx = LBa = (u32x4){0u, 0u, 0u, 0u};
        const int cv = h * 64 + q * 16 + 2 * cgp;
        const int rl = lane >> 4, kq = lane & 15, rowl = (wid & 3) * 4 + rl;
        f32x2 s01 = (f32x2){0.f, 0.f}, s23 = (f32x2){0.f, 0.f}; float yacc = 0.f;
#define CHUNK_ROW(c, t) ((c) == 0 ? NREAL + (t) : b * SEQ + ((c) - 1) * TC + (t))
#define ISSUE_LOADS(L, c) do { const bool valid_ = ((c) > 0) || (tt < NMETA); if (valid_) { const int row_ = CHUNK_ROW(c, tt); const int pr_ = prev_row(row_); \
            const bf16_t* a_ = p + (size_t)row_ * NP + c0; L##r0 = *(const u32x4*)(a_ + PC_R); L##k0 = *(const u32x4*)(a_ + PC_K); L##v0 = *(const unsigned*)(p + (size_t)row_ * NP + PC_V + cv); \
            L##x = *(const u32x4*)(xb + (size_t)row_ * DB + c0); L##a = *(const u32x4*)(ab + (size_t)row_ * DB + c0); \
            if (pr_ >= 0) { const bf16_t* a1_ = p + (size_t)pr_ * NP + c0; L##r1 = *(const u32x4*)(a1_ + PC_R); L##k1 = *(const u32x4*)(a1_ + PC_K); L##v1 = *(const unsigned*)(p + (size_t)pr_ * NP + PC_V + cv); } \
            else { L##r1 = L##k1 = (u32x4){0u, 0u, 0u, 0u}; L##v1 = 0u; } } } while (0)
        if (wid >= 4) {
            if (j < 96) {
                const float* mu = P.mu + (size_t)l * 8384; const int arr = j >> 4, c4 = h * 64 + (j & 15) * 4;
                const float* src = arr == 0 ? mu + c4 : arr == 1 ? mu + 2048 + c4 : arr == 2 ? mu + 4096 + c4 : arr == 3 ? P.kks + (size_t)l * DB + c4 : arr == 4 ? P.kas + (size_t)l * DB + c4 : P.rk + (size_t)l * DB + c4;
                ((LAS f32x4*)(lds + 2 * SC_BUF))[j] = *(const f32x4*)src;
            }
            ISSUE_LOADS(LA, 0); ISSUE_LOADS(LB, 1);
        } else {
            __builtin_amdgcn_s_setprio(2);
        }
        __syncthreads();
        float mur[8], muk[8], kks[8], kas[8], rks[8]; const float muva = P.mu[(size_t)l * 8384 + 4096 + cv], muvb = P.mu[(size_t)l * 8384 + 4096 + cv + 1];
        { LAS const f32x4* cst_ = (LAS const f32x4*)(lds + 2 * SC_BUF) + cgp * 2;
#pragma unroll
          for (int e = 0; e < 4; ++e) { mur[e] = cst_[0][e]; mur[4 + e] = cst_[1][e]; muk[e] = cst_[16][e]; muk[4 + e] = cst_[17][e]; kks[e] = cst_[48][e]; kks[4 + e] = cst_[49][e];
              kas[e] = cst_[64][e]; kas[4 + e] = cst_[65][e]; rks[e] = cst_[80][e]; rks[4 + e] = cst_[81][e]; } }
#define SCAN_ITER(L, i) do { \
            if (wid >= 4) { \
                if ((i) >= 2 && (i) - 2 < NCH) {     \
                    const int c = (i) - 2; const bool valid = (c > 0) ? true : (tt < NMETA && b == 0); \
                    if (valid) { const LAS f32x2* yb = (const LAS f32x2*)(lds + ((i) & 1) * SC_BUF + SC_Y + tt * 64) + cgp; const f32x2 y = *yb; \
                        const f32x4 vc_ = *((const LAS f32x4*)(lds + ((i) & 1) * SC_BUF + SC_V + tt * 128) + cgp); \
                        *(unsigned*)(sb + (size_t)CHUNK_ROW(c, tt) * DB + h * 64 + q * 16 + 2 * cgp) = cvt_pk_bf16(y.x + vc_.y, y.y + vc_.w); } \
                } \
                if ((i) < NCH) { \
                    LAS unsigned char* buf = lds + ((i) & 1) * SC_BUF; \
                    const bool valid = ((i) > 0) || (tt < NMETA); \
                    float r0[8], r1[8], k0[8], k1[8], xx[8], aa[8]; \
                    unpack8(L##r0, r0); unpack8(L##r1, r1); unpack8(L##k0, k0); unpack8(L##k1, k1); unpack8h(L##x, xx); unpack8h(L##a, aa); \
                    float rr[8], kp[8], kkv[8], dec[8]; float ss = 0.f; \
                    _Pragma("unroll") for (int e = 0; e < 8; ++e) { rr[e] = r0[e] + mur[e] * (r1[e] - r0[e]); kp[e] = k0[e] + muk[e] * (k1[e] - k0[e]); dec[e] = __expf(-xx[e]); \
                        kkv[e] = kp[e] * kks[e]; ss += kkv[e] * kkv[e]; } \
                    ss = allred8(ss); \
                    const float inv = __builtin_amdgcn_rsqf(fmaxf(ss, 1e-24f)); \
                    float kk[8], kka[8], kt[8], wr[8]; float bs = 0.f, c1 = 0.f, c2 = 0.f; \
                    _Pragma("unroll") for (int e = 0; e < 8; ++e) { kk[e] = kkv[e] * inv; kka[e] = kk[e] * aa[e]; kt[e] = kp[e] * (1.0f + (aa[e] - 1.0f) * kas[e]); bs += rr[e] * kt[e] * rks[e]; \
                        wr[e] = dec[e] * rr[e]; c1 += kka[e] * rr[e]; c2 += kt[e] * rr[e]; } \
                    bs = allred8(bs); c1 = allred8(c1); c2 = allred8(c2); \
                    if (valid) { \
                        LAS f32x4* o = (LAS f32x4*)(buf + SC_OPND + tt * REC) + cgp * 2; \
                        float rp[8]; _Pragma("unroll") for (int e = 0; e < 8; ++e) rp[e] = wr[e] - c1 * kk[e]; \
                        o[0] = (f32x4){kk[0], rp[0], kk[1], rp[1]}; o[1] = (f32x4){kk[4], rp[4], kk[5], rp[5]}; \
                        o[16] = (f32x4){kk[2], rp[2], kk[3], rp[3]}; o[17] = (f32x4){kk[6], rp[6], kk[7], rp[7]}; \
                        o[32] = (f32x4){dec[0], dec[1], dec[2], dec[3]}; o[33] = (f32x4){dec[4], dec[5], dec[6], dec[7]}; \
                        o[48] = (f32x4){kka[0], kka[1], kka[2], kka[3]}; o[49] = (f32x4){kka[4], kka[5], kka[6], kka[7]}; \
                        o[64] = (f32x4){kt[0], kt[1], kt[2], kt[3]}; o[65] = (f32x4){kt[4], kt[5], kt[6], kt[7]}; \
                        { const float v0a_ = bf_lo(L##v0), v0b_ = bf_hi(L##v0), v1a_ = bf_lo(L##v1), v1b_ = bf_hi(L##v1); \
                          const float vva_ = v0a_ + muva * (v1a_ - v0a_), vvb_ = v0b_ + muvb * (v1b_ - v0b_); \
                          *((LAS f32x4*)(buf + SC_V + tt * 128) + cgp) = (f32x4){vva_, vva_ * c2, vvb_, vvb_ * c2}; }     \
                        if (q == 0 && cgp == 0 && ((i) > 0 || b == 0)) bon[(size_t)CHUNK_ROW(i, tt) * 32 + h] = bs; \
                    } \
                } \
                if ((i) + 2 < NCH) ISSUE_LOADS(L, (i) + 2); \
            } else { \
                if ((i) >= 1 && (i) <= NCH) { \
                    const int c = (i) - 1; const int ntok = c == 0 ? NMETA : TC; \
                    LAS const unsigned char* buf = lds + (c & 1) * SC_BUF; \
                    LAS float* ybuf = (LAS float*)(lds + (c & 1) * SC_BUF + SC_Y) + (15 - kq) * 16 + rowl; \
                    f32x4 Akra, Akrb, Aw, Aka, Ak, Bkra, Bkrb, Bw, Bka, Bk; f32x2 Av, Bv; \
                    LAS const unsigned char* ob = buf + SC_OPND + kq * 16; LAS const unsigned char* vb = buf + SC_V + rowl * 8; \
                    LOADOPS(A, 0); \
                    _Pragma("unroll 1") for (int g = 0; g < ntok; g += 16) { \
                        asm volatile("" : "+v"(ob), "+v"(vb));     \
                        _Pragma("unroll") for (int u = 0; u < 8; ++u) { LOADOPS(B, 2 * u + 1); STEP(A); LOADOPS(A, 2 * u + 2); STEP(B); } \
                        ob += 16 * REC; vb += 16 * 128; \
                        ybuf[g * 16] = yacc; } \
                } \
            } \
            SCAN_BARRIER(); } while (0)
#define LOADOPS(S, t) do { S##kra = *(LAS const f32x4*)(ob + (t) * REC); S##krb = *(LAS const f32x4*)(ob + (t) * REC + 256); S##w = *(LAS const f32x4*)(ob + (t) * REC + 512); \
                        S##ka = *(LAS const f32x4*)(ob + (t) * REC + 768); S##k = *(LAS const f32x4*)(ob + (t) * REC + 1024); S##v = *(LAS const f32x2*)(vb + (t) * 128); } while (0)
#define LO2(v) __builtin_shufflevector(v, v, 0, 1)
#define HI2(v) __builtin_shufflevector(v, v, 2, 3)
#define STEP(S) do { \
                        f32x2 P_ = (f32x2){s01.x, s01.x} * LO2(S##kra); \
                        P_ = (f32x2){s01.y, s01.y} * HI2(S##kra) + P_; \
                        P_ = (f32x2){s23.x, s23.x} * LO2(S##krb) + P_; \
                        P_ = (f32x2){s23.y, s23.y} * HI2(S##krb) + P_; \
                        float sa_ = P_.x, yp_ = P_.y; \
                        f32x2 m01_ = s01 * LO2(S##w), m23_ = s23 * HI2(S##w); \
                        sa_ += dpp_mov<0xB1>(sa_); yp_ += dpp_mov<0xB1>(yp_); \
                        m01_ = (f32x2){S##v.x, S##v.x} * LO2(S##k) + m01_; \
                        sa_ += dpp_mov<0x4E>(sa_); yp_ += dpp_mov<0x4E>(yp_); \
                        m23_ = (f32x2){S##v.x, S##v.x} * HI2(S##k) + m23_; \
                        sa_ += dpp_mov<0x141>(sa_); yp_ += dpp_mov<0x141>(yp_); sa_ += dpp_mov<0x128>(sa_); yp_ += dpp_mov<0x128>(yp_); \
                        const f32x2 sa2_ = (f32x2){sa_, sa_}; \
                        s01 = m01_ - sa2_ * LO2(S##ka); s23 = m23_ - sa2_ * HI2(S##ka); \
                        yacc = __builtin_bit_cast(float, __builtin_amdgcn_update_dpp(__builtin_bit_cast(int, yp_), __builtin_bit_cast(int, yacc), 0x111, 0xf, 0xf, false)); } while (0)
#pragma unroll 1
        for (int i = 0; i < NCH + 2; i += 2) { SCAN_ITER(LA, i); SCAN_ITER(LB, i + 1); }
        if (wid < 4) __builtin_amdgcn_s_setprio(0);
        __syncthreads();
    }
}

__device__ __forceinline__ void p3b_phase(const Params& P, int l, size_t gtid, size_t gthreads) {
    const bf16_t* p = (const bf16_t*)(P.ws + WS_P); bf16_t* sb = (bf16_t*)(P.ws + WS_SB); const float* bon = (const float*)(P.ws + WS_BON);
    const float* mu = P.mu + (size_t)l * 8384; const float* gg = P.gn_g + (size_t)l * DB; const float* gb = P.gn_b + (size_t)l * DB;
    const size_t tot = (size_t)NRUN * 256;
    for (size_t it = gtid; it < tot; it += gthreads) {
        const int run = (int)(it >> 8), h = (int)((it >> 3) & 31), c0 = h * 64 + (int)(it & 7) * 8; const int row0 = run * RUN; const int r1 = prev_row(row0);
        float mv[8], mz[8], g8[8], b8[8], v1[8], z1[8];
#pragma unroll
        for (int e = 0; e < 8; ++e) { mv[e] = mu[4096 + c0 + e]; mz[e] = mu[6144 + c0 + e]; g8[e] = gg[c0 + e]; b8[e] = gb[c0 + e]; v1[e] = 0.f; z1[e] = 0.f; }
        if (r1 >= 0) { unpack8(*(const u32x4*)(p + (size_t)r1 * NP + PC_V + c0), v1); unpack8(*(const u32x4*)(p + (size_t)r1 * NP + PC_Z + c0), z1); }
        u32x4 Ly[RUN], Lv[RUN], Lz[RUN]; float Lb[RUN];
#pragma unroll
        for (int rr = 0; rr < RUN; ++rr) { const size_t row = (size_t)(row0 + rr); Ly[rr] = *(const u32x4*)(sb + row * DB + c0); Lv[rr] = *(const u32x4*)(p + row * NP + PC_V + c0); Lz[rr] = *(const u32x4*)(p + row * NP + PC_Z + c0); Lb[rr] = bon[row * 32 + h]; }
#pragma unroll
        for (int rr = 0; rr < RUN; ++rr) {
            float y[8], v0[8], z0[8], o[8]; unpack8(Ly[rr], y); unpack8(Lv[rr], v0); unpack8(Lz[rr], z0);
            float s1 = 0.f;
#pragma unroll
            for (int e = 0; e < 8; ++e) s1 += y[e];
            const float mean = allred8(s1) * (1.f / 64.f); float s2 = 0.f;
#pragma unroll
            for (int e = 0; e < 8; ++e) { y[e] -= mean; s2 += y[e] * y[e]; }
            const float rstd = __builtin_amdgcn_rsqf(allred8(s2) * (1.f / 64.f) + GN_EPS); const float bs = Lb[rr];
#pragma unroll
            for (int e = 0; e < 8; ++e) { const float vp = v0[e] + mv[e] * (v1[e] - v0[e]); const float zp = z0[e] + mz[e] * (z1[e] - z0[e]);
                o[e] = (y[e] * rstd * g8[e] + b8[e] + bs * vp) * siluf_(zp); v1[e] = v0[e]; z1[e] = z0[e]; }
            *(u32x4*)(sb + (size_t)(row0 + rr) * DB + c0) = pack8(o);
        }
    }
}

constexpr size_t WS_DBG = WS_END;
__device__ __forceinline__ void dbg_fail(const Params& P, unsigned bit) { atomicOr((unsigned*)(P.ws + WS_DBG), bit); }
__device__ __forceinline__ float bf2f(bf16_t v) { return __uint_as_float((unsigned)v << 16); }
__device__ __forceinline__ float h2f(unsigned short v) { return (float)__builtin_bit_cast(_Float16, v); }
__device__ __forceinline__ void chk_gemm1(const Params& P, int gw, int ngw, int lane) {
    const bf16_t* hb = (const bf16_t*)(P.ws + WS_HB); const bf16_t* wt = (const bf16_t*)(P.ws + WS_WIN); const bf16_t* p = (const bf16_t*)(P.ws + WS_P);
    for (int i = gw; i < 4096; i += ngw) { const int row = (int)(((long)i * 977) % NROWS), col = (int)(((long)i * 613) % NP);
        float s = 0.f; for (int k = lane; k < D; k += 64) s += bf2f(hb[(size_t)row * D + k]) * bf2f(wt[(size_t)col * D + k]);
        s = wave_sum(s); const float got = bf2f(p[(size_t)row * NP + col]);
        if (lane == 0 && !(fabsf(got - s) <= 0.03f + 0.02f * fabsf(s))) dbg_fail(P, 1u); }
}
__device__ __forceinline__ void chk_lora(const Params& P, int l, int gw, int ngw, int lane) {
    const bf16_t* al = (const bf16_t*)(P.ws + WS_AL); const bf16_t* wl = (const bf16_t*)(P.ws + WS_WL) + (size_t)l * 4096 * 256;
    const unsigned short* xb = (const unsigned short*)(P.ws + WS_HB); const unsigned short* ab = (const unsigned short*)(P.ws + WS_AB);
    for (int i = gw; i < 4096; i += ngw) { const int row = (int)(((long)i * 977) % NROWS), c = (int)(((long)i * 613) % DB);
        float s1 = 0.f, s2 = 0.f; for (int k = lane; k < 256; k += 64) { const float av = bf2f(al[(size_t)row * 256 + k]); s1 += av * bf2f(wl[(size_t)c * 256 + k]); s2 += av * bf2f(wl[(size_t)(2048 + c) * 256 + k]); }
        s1 = wave_sum(s1); s2 = wave_sum(s2);
        const float xr = 0.60653065971f / (1.f + expf(-(P.w0[(size_t)l * DB + c] + s1))), ar = 1.f / (1.f + expf(-(P.a0[(size_t)l * DB + c] + s2)));
        const float xg = h2f(xb[(size_t)row * DB + c]), ag = h2f(ab[(size_t)row * DB + c]);
        if (lane == 0 && !(fabsf(xg - xr) <= 1e-4f + 0.01f * fabsf(xr))) dbg_fail(P, 2u);
        if (lane == 0 && !(fabsf(ag - ar) <= 1e-3f + 0.01f * fabsf(ar))) dbg_fail(P, 4u); }
}
__device__ __forceinline__ void chk_scan(const Params& P, int l, LAS unsigned char* lds, int gw, int wid, int lane) {
    if (gw >= 8) return;
    const int b = gw & 1, h = (gw * 5 + 3) & 31;
    LAS float* S = (LAS float*)(lds + wid * 16384); LAS float* op = S + 64 * 49;
    const bf16_t* p = (const bf16_t*)(P.ws + WS_P); const unsigned short* xb = (const unsigned short*)(P.ws + WS_HB); const unsigned short* ab = (const unsigned short*)(P.ws + WS_AB);
    const bf16_t* sb = (const bf16_t*)(P.ws + WS_SB); const float* bon = (const float*)(P.ws + WS_BON);
    const float* mu = P.mu + (size_t)l * 8384; const int c = h * 64 + lane;
    (void)S; (void)op;
    LAS float* st = S + lane * 64;
    for (int k = 0; k < 64; ++k) st[(k + lane) & 63] = 0.f;
    const float mur = mu[c], muk = mu[2048 + c], muv = mu[4096 + c], kks = P.kks[(size_t)l * DB + c], kas = P.kas[(size_t)l * DB + c], rks = P.rk[(size_t)l * DB + c];
    for (int tau = 0; tau < 16 + 40; ++tau) {
        const int row = tau < 16 ? NREAL + tau : b * SEQ + (tau - 16); const int pr = prev_row(row);
        const float r0 = bf2f(p[(size_t)row * NP + PC_R + c]), k0 = bf2f(p[(size_t)row * NP + PC_K + c]), v0 = bf2f(p[(size_t)row * NP + PC_V + c]);
        const float r1 = pr >= 0 ? bf2f(p[(size_t)pr * NP + PC_R + c]) : 0.f, k1 = pr >= 0 ? bf2f(p[(size_t)pr * NP + PC_K + c]) : 0.f, v1 = pr >= 0 ? bf2f(p[(size_t)pr * NP + PC_V + c]) : 0.f;
        const float rr = r0 + mur * (r1 - r0), kp = k0 + muk * (k1 - k0), vp = v0 + muv * (v1 - v0);
        const float x = h2f(xb[(size_t)row * DB + c]), a = h2f(ab[(size_t)row * DB + c]);
        const float w = expf(-x); const float kkv = kp * kks; const float nrm = sqrtf(wave_sum(kkv * kkv)); const float kk = kkv / fmaxf(nrm, 1e-12f);
        const float kka = kk * a, kt = kp * (1.f + (a - 1.f) * kas);
        const float bs = wave_sum(rr * kt * rks);
        float sa = 0.f;
#pragma unroll 1
        for (int k = 0; k < 64; ++k) sa += st[(k + lane) & 63] * __shfl(kk, k);
        float y = 0.f;
#pragma unroll 1
        for (int k = 0; k < 64; ++k) { const float nv = st[(k + lane) & 63] * __shfl(w, k) - sa * __shfl(kka, k) + vp * __shfl(kt, k); st[(k + lane) & 63] = nv; y += nv * __shfl(rr, k); }
        if (tau >= 16 || b == 0) {
            const float yg = bf2f(sb[(size_t)row * DB + c]);
            if (!(fabsf(yg - y) <= 0.02f + 0.02f * fabsf(y))) dbg_fail(P, 8u);
            if (lane == 0 && !(fabsf(bon[(size_t)row * 32 + h] - bs) <= 1e-3f + 1e-3f * fabsf(bs))) dbg_fail(P, 16u);
        }
    }
}
__device__ __forceinline__ void chk_merged(const Params& P, int l, int gw, int ngw, int lane) {
    const bf16_t* co = (const bf16_t*)(P.ws + WS_CO); const bf16_t* sb = (const bf16_t*)(P.ws + WS_SB); const bf16_t* p = (const bf16_t*)(P.ws + WS_P); const bf16_t* mg = (const bf16_t*)(P.ws + WS_HB);
    const bf16_t* wa = (const bf16_t*)(P.ws + WS_WA) + (size_t)l * D * DA; const bf16_t* wb = (const bf16_t*)(P.ws + WS_WB) + (size_t)l * D * DB;
    for (int i = gw; i < 4096; i += ngw) { const int row = (int)(((long)i * 977) % NROWS), c = (int)(((long)i * 613) % D);
        float s1 = 0.f, s2 = 0.f; for (int k = lane; k < DA; k += 64) s1 += bf2f(co[(size_t)row * DA + k]) * bf2f(wa[(size_t)c * DA + k]);
        for (int k = lane; k < DB; k += 64) s2 += bf2f(sb[(size_t)row * DB + k]) * bf2f(wb[(size_t)c * DB + k]);
        s1 = wave_sum(s1); s2 = wave_sum(s2);
        const float ga = 1.f / (1.f + expf(-bf2f(p[(size_t)row * NP + PC_GA + c]))), gb = 1.f / (1.f + expf(-bf2f(p[(size_t)row * NP + PC_GB + c])));
        const float m = ga * s1 + gb * s2, got = bf2f(mg[(size_t)row * D + c]);
        if (lane == 0 && !(fabsf(got - m) <= 0.01f + 0.03f * fabsf(m))) dbg_fail(P, 32u); }
}

#define XB_TMO      128
#define XB_XCNT(j)  (256  + 64 * (j))
#define XB_XSUB(j)  (1280 + 64 * (j))
#define XB_XGEN(j)  (2304 + 64 * (j))
#define XB_TOP      3328
#define XB_TOPGEN   3392
#define XCD_BAR_WORDS 3456
#define XB_SPIN_CAP (1u << 18)
__device__ __forceinline__ unsigned xb_ld(unsigned* p)              { return __hip_atomic_load(p, __ATOMIC_RELAXED, __HIP_MEMORY_SCOPE_AGENT); }
__device__ __forceinline__ unsigned xb_add(unsigned* p, unsigned v) { return __hip_atomic_fetch_add(p, v, __ATOMIC_RELAXED, __HIP_MEMORY_SCOPE_AGENT); }
__device__ __forceinline__ unsigned xb_xcc_id() { return (unsigned)__builtin_amdgcn_s_getreg((3 << 11) | 20) & 0xFu; }
#define XB_SPIN(cond, bar) do { unsigned _sp = 0; while (cond) { __builtin_amdgcn_s_sleep(1); \
    if ((++_sp & 255u) == 0u) { if (xb_ld(&(bar)[XB_TMO])) break; if (_sp > XB_SPIN_CAP) { atomicAdd(&(bar)[XB_TMO], 1u); break; } } } } while (0)
struct XcdBarrier { unsigned* bar; unsigned x; volatile LAS unsigned* st; };
__device__ __forceinline__ void xcd_barrier_complete(unsigned* bar, unsigned x, unsigned& nloc, unsigned& nx) {
    const unsigned G = gridDim.x * gridDim.y * gridDim.z;
    unsigned sum, cnt, mine, sp = 0u;
    for (;;) {
        sum = 0u; cnt = 0u; mine = 0u;
#pragma unroll
        for (unsigned j = 0; j < 16; ++j) { const unsigned c = xb_ld(&bar[XB_XCNT(j)]); sum += c; cnt += (c > 0u) ? 1u : 0u; mine = (j == x) ? c : mine; }
        if (sum == G) break;
        __builtin_amdgcn_s_sleep(1);
        if ((++sp & 255u) == 0u) { if (xb_ld(&bar[XB_TMO])) break; if (sp > XB_SPIN_CAP) { atomicAdd(&bar[XB_TMO], 1u); break; } }
    }
    nloc = mine > 0u ? mine : 1u; nx = cnt > 0u ? cnt : 1u;
}
__device__ __forceinline__ void xcd_barrier(const XcdBarrier& b) {
    asm volatile("s_waitcnt vmcnt(0)" ::: "memory");
    __syncthreads();
    if (threadIdx.x == 0) {
        unsigned* bar = b.bar;
        __builtin_amdgcn_s_waitcnt(0);
        unsigned nloc = b.st[0], nx = b.st[1];
        if (nloc == 0u) { xcd_barrier_complete(bar, b.x, nloc, nx); b.st[0] = nloc; b.st[1] = nx; }
        const unsigned old = xb_add(&bar[XB_XSUB(b.x)], 1u);
        const unsigned gen = old / nloc;
        if (old + 1u == (gen + 1u) * nloc) {
            __builtin_amdgcn_fence(__ATOMIC_RELEASE, "agent");
            asm volatile("s_waitcnt vmcnt(0)" ::: "memory");
            const unsigned og = xb_add(&bar[XB_TOP], 1u);
            const unsigned tg = og / nx;
            if (og + 1u == (tg + 1u) * nx) xb_add(&bar[XB_TOPGEN], 1u);
            else XB_SPIN(xb_ld(&bar[XB_TOPGEN]) == tg, bar);
            __builtin_amdgcn_fence(__ATOMIC_ACQUIRE, "agent");
            xb_add(&bar[XB_XGEN(b.x)], 1u);
            asm volatile("s_waitcnt vmcnt(0)" ::: "memory");
        } else {
            XB_SPIN(xb_ld(&bar[XB_XGEN(b.x)]) == gen, bar);
            __builtin_amdgcn_fence(__ATOMIC_ACQUIRE, "agent");
            asm volatile("s_waitcnt vmcnt(0)" ::: "memory");
        }
    }
    __syncthreads();
}
constexpr size_t WS_BAR = WS_END + 4096;
constexpr int LDS_XB = 131072;
#define LAUNDER(v) asm volatile("" : "+v"(v))
#if defined(__HIP_DEVICE_COMPILE__)
#define GETPARAMS const Params P = *Pp
#else
#define GETPARAMS const Params P = Pformal
#endif
__global__ void __launch_bounds__(512, 2) fwd_megakernel(Params Pformal) {
    extern __shared__ __attribute__((aligned(16))) unsigned char shm[];
    LAS unsigned char* lds = (LAS unsigned char*)shm;
    cg::grid_group grid = cg::this_grid();
    const int G = gridDim.x;
#if defined(__HIP_DEVICE_COMPILE__)
#define WS_PTR() (((const __attribute__((address_space(4))) Params*)__builtin_amdgcn_kernarg_segment_ptr())->ws)
#else
#define WS_PTR() (Pformal.ws)
#endif
#define GRID_BAR() do { XcdBarrier b_; b_.bar = (unsigned*)(WS_PTR() + WS_BAR); b_.x = xb_xcc_id(); b_.st = (volatile LAS unsigned*)(lds + LDS_XB); xcd_barrier(b_); } while (0)
    { unsigned* bar0 = (unsigned*)(WS_PTR() + WS_BAR); for (int i = blockIdx.x * 512 + threadIdx.x; i < XCD_BAR_WORDS; i += G * 512) bar0[i] = 0u;
      if (threadIdx.x == 0) { ((volatile LAS unsigned*)(lds + LDS_XB))[0] = 0u; ((volatile LAS unsigned*)(lds + LDS_XB))[1] = 0u; } }
#define TIDS() const __attribute__((address_space(4))) Params* Pp = (const __attribute__((address_space(4))) Params*)__builtin_amdgcn_kernarg_segment_ptr(); asm volatile("" : "+s"(Pp)); GETPARAMS; \
    bf16_t* hb = (bf16_t*)(P.ws + WS_HB); bf16_t* pbuf = (bf16_t*)(P.ws + WS_P); (void)hb; (void)pbuf; \
    int tid = threadIdx.x; LAUNDER(tid); const int wid = __builtin_amdgcn_readfirstlane(tid >> 6), lane = tid & 63; const int gw = blockIdx.x * 8 + wid, ngw = G * 8; (void)lane; (void)gw; (void)ngw
    { TIDS();
#ifdef DBG_CHECKS
      if (blockIdx.x == 0 && tid == 0) *(unsigned*)(P.ws + WS_DBG) = 0u;
#endif
      convert_small(P, lds, gw, ngw, wid, lane); }
    { TIDS(); convert_win(P, 0, lds, gw, ngw, wid, lane); }
    { TIDS(); embed_phase(P, gw, ngw, lane); }
    grid.sync();
    if (threadIdx.x == 0) (void)xb_add(&((unsigned*)(WS_PTR() + WS_BAR))[XB_XCNT(xb_xcc_id())], 1u);
    for (int l = 0; l < DEPTH; ++l) {
        {
            TIDS();
            pg8::Gemm g{hb, (const bf16_t*)(P.ws + WS_WIN), MPAD, NP, D}; pg8::StaticOrder S; S.init(MPAD, NP, G, blockIdx.x);
            EpiP E{pbuf}; pg8::gemm_run(lds, g, S, E, tid);
        }
        GRID_BAR();
#ifdef DBG_CHECKS
        if (l == 0) { TIDS(); chk_gemm1(P, gw, ngw, lane); }
#endif
        { TIDS(); p2_phase(P, l, (size_t)blockIdx.x * 512 + tid, (size_t)G * 512); }
        GRID_BAR();
        {
            TIDS();
            pg8::Gemm g{(const bf16_t*)(P.ws + WS_AL), (const bf16_t*)(P.ws + WS_WL) + (size_t)l * 4096 * 256, MPAD, 4096, 256}; pg8::StaticOrder S; S.init(MPAD, 4096, G, blockIdx.x);
            EpiLora E{(unsigned short*)(P.ws + WS_HB), (unsigned short*)(P.ws + WS_AB), P.w0 + (size_t)l * DB, P.a0 + (size_t)l * DB}; pg8::gemm_run(lds, g, S, E, tid);
        }
        GRID_BAR();
#ifdef DBG_CHECKS
        if (l == 0) { TIDS(); chk_lora(P, l, gw, ngw, lane); }
#endif
        { TIDS(); scan_phase(P, l, lds, tid); }
        GRID_BAR();
#ifdef DBG_CHECKS
        if (l == 0) { TIDS(); chk_scan(P, l, lds, gw, wid, lane); GRID_BAR(); }
#endif
        { TIDS(); p3b_phase(P, l, (size_t)blockIdx.x * 512 + tid, (size_t)G * 512); }
        if (l + 1 < DEPTH) { TIDS(); convert_win(P, l + 1, lds, gw, ngw, wid, lane); }
        GRID_BAR();
        {
            TIDS();
            pg8::StaticOrder S; S.init(NREAL, D, G, blockIdx.x);
            pg8::Gemm ga{(const bf16_t*)(P.ws + WS_CO), (const bf16_t*)(P.ws + WS_WA) + (size_t)l * D * DA, NREAL, D, DA};
            EpiY<false> Ea{hb, pbuf, PC_GA}; pg8::gemm_run(lds, ga, S, Ea, tid);
        }
        {
            TIDS();
            pg8::StaticOrder S; S.init(NREAL, D, G, blockIdx.x);
            pg8::Gemm gb{(const bf16_t*)(P.ws + WS_SB), (const bf16_t*)(P.ws + WS_WB) + (size_t)l * D * DB, NREAL, D, DB};
            EpiY<true> Eb{hb, pbuf, PC_GB}; pg8::gemm_run(lds, gb, S, Eb, tid);
        }
        { TIDS(); meta_p4(P, l, lds, wid, lane); }
        GRID_BAR();
#ifdef DBG_CHECKS
        if (l == 0) { TIDS(); chk_merged(P, l, gw, ngw, lane); }
#endif
        {
            TIDS();
            pg8::StaticOrder S; S.init(NREAL, D, G, blockIdx.x);
            pg8::Gemm g{hb, (const bf16_t*)(P.ws + WS_WO) + (size_t)l * D * D, NREAL, D, D};
            EpiOut E{(float*)(P.ws + WS_HF)}; pg8::gemm_run(lds, g, S, E, tid);
        }
        { TIDS(); meta_p5(P, l, lds, wid, lane); }
        GRID_BAR();
        { TIDS(); ln_phase(P, l, gw, ngw, lane); }
        if (l + 1 < DEPTH) GRID_BAR();
    }
#ifdef DBG_CHECKS
    GRID_BAR();
    { TIDS(); if (blockIdx.x == 0 && tid == 0) { const unsigned f = *(volatile unsigned*)(P.ws + WS_DBG); if (f) P.out[0] = 100.f * (float)(10 + f); } }
#endif
}

constexpr int LDS_BYTES = 131072 + 16;
extern "C" void kernel_launch(void* const* d_in, const int* in_sizes, int n_in, void* d_out, int out_size, void* d_ws, size_t ws_size, hipStream_t stream) {
    static int grid_blocks = 0;
    if (grid_blocks == 0) {
        if (n_in != 21 || ws_size < WS_BAR + 16384) { fprintf(stderr, "kernel_launch: unexpected n_in %d / ws_size %zu (need %zu)\n", n_in, ws_size, (size_t)WS_END); grid_blocks = -1; return; }
        int dev = 0, cus = 0, per_cu = 0;
        hipGetDevice(&dev); hipDeviceGetAttribute(&cus, hipDeviceAttributeMultiprocessorCount, dev);
        if (hipFuncSetAttribute((const void*)fwd_megakernel, hipFuncAttributeMaxDynamicSharedMemorySize, LDS_BYTES) != hipSuccess) fprintf(stderr, "kernel_launch: hipFuncSetAttribute failed\n");
        if (hipOccupancyMaxActiveBlocksPerMultiprocessor(&per_cu, (const void*)fwd_megakernel, 512, LDS_BYTES) != hipSuccess || per_cu < 1) { fprintf(stderr, "kernel_launch: occupancy query gave %d\n", per_cu); per_cu = 1; }
        (void)hipGetLastError();
        grid_blocks = cus * per_cu;
        if (grid_blocks > 256) grid_blocks = 256;
    }
    if (grid_blocks < 0) return;
    Params p{};
    const float** pp = (const float**)&p;
    for (int i = 0; i < 21; ++i) pp[i] = (const float*)d_in[i];
    p.out = (float*)d_out; p.ws = (unsigned char*)d_ws;
    void* args[] = {&p};
    hipError_t e = hipLaunchCooperativeKernel((const void*)fwd_megakernel, dim3(grid_blocks), dim3(512), args, LDS_BYTES, stream);
    if (e != hipSuccess) fprintf(stderr, "cooperative launch failed: %s (grid %d)\n", hipGetErrorString(e), grid_blocks);
}
```

```cpp
#include <hip/hip_runtime.h>
#include <hip/hip_cooperative_groups.h>
#include <cstdio>
#include <cstdint>
namespace cg = cooperative_groups;

#define LAS __attribute__((address_space(3)))
typedef unsigned short bf16_t;
typedef short bf16x8 __attribute__((ext_vector_type(8)));
typedef float f32x4 __attribute__((ext_vector_type(4)));
typedef float f32x2 __attribute__((ext_vector_type(2)));
typedef unsigned u32x4 __attribute__((ext_vector_type(4)));
typedef unsigned u32x2 __attribute__((ext_vector_type(2)));
typedef _Float16 h16x2 __attribute__((ext_vector_type(2)));

constexpr int D = 2048, SEQ = 16384, NBATCH = 2, DEPTH = 4;
constexpr int NREAL = NBATCH * SEQ;
constexpr int NMETA = 16;
constexpr int NROWS = NREAL + NMETA;
constexpr int MPAD = 33024;
constexpr int NCOLS = 16576, NP = 16640;
constexpr int DA = 1024, DB = 2048, NHEAD = 32, LORA = 96;
constexpr int PC_XIN = 0, PC_BG = 1024, PC_CG = 2048, PC_ZA = 3072, PC_R = 4096, PC_K = 6144, PC_V = 8192, PC_Z = 10240,
              PC_GA = 12288, PC_GB = 14336, PC_WLO = 16384, PC_ALO = 16480;
constexpr float LN_EPS = 1e-5f, GN_EPS = 6.4e-4f;
constexpr float ALPHA = 1.6817928305074292f;

constexpr size_t al256(size_t x) { return (x + 255) & ~(size_t)255; }
constexpr size_t WS_WIN = 0;
constexpr size_t WS_WA = al256(WS_WIN + (size_t)NP * D * 2);
constexpr size_t WS_WB = al256(WS_WA + (size_t)DEPTH * D * DA * 2);
constexpr size_t WS_WO = al256(WS_WB + (size_t)DEPTH * D * DB * 2);
constexpr size_t WS_WL = al256(WS_WO + (size_t)DEPTH * D * D * 2);
constexpr size_t WS_HF = al256(WS_WL + (size_t)DEPTH * 4096 * 256 * 2);
constexpr size_t WS_HB = al256(WS_HF + (size_t)MPAD * D * 4);
constexpr size_t WS_P = al256(WS_HB + (size_t)MPAD * D * 2);
constexpr size_t WS_CO = al256(WS_P + (size_t)MPAD * NP * 2);
constexpr size_t WS_SB = al256(WS_CO + (size_t)MPAD * DA * 2);
constexpr size_t WS_AB = al256(WS_SB + (size_t)MPAD * DB * 2);
constexpr size_t WS_AL = al256(WS_AB + (size_t)MPAD * DB * 2);
constexpr size_t WS_BON = al256(WS_AL + (size_t)MPAD * 256 * 2);
constexpr size_t WS_END = al256(WS_BON + (size_t)MPAD * 32 * 4);

struct Params {
    const float *x, *meta, *emb_g, *emb_b, *w_in, *conv_w, *w_a, *mu, *w0, *w2, *a0, *a2, *kks, *kas, *rk, *gn_g, *gn_b, *w_b, *w_out, *ln_g, *ln_b;
    float* out; unsigned char* ws;
};

__device__ __forceinline__ unsigned cvt_pk_bf16(float lo, float hi) { unsigned r; asm volatile("v_cvt_pk_bf16_f32 %0, %1, %2" : "=v"(r) : "v"(lo), "v"(hi)); return r; }
__device__ __forceinline__ float bf_lo(unsigned w) { return __uint_as_float(w << 16); }
__device__ __forceinline__ float bf_hi(unsigned w) { return __uint_as_float(w & 0xffff0000u); }
__device__ __forceinline__ void unpack8(const u32x4 w, float (&f)[8]) {
    f[0] = bf_lo(w.x); f[1] = bf_hi(w.x); f[2] = bf_lo(w.y); f[3] = bf_hi(w.y); f[4] = bf_lo(w.z); f[5] = bf_hi(w.z); f[6] = bf_lo(w.w); f[7] = bf_hi(w.w);
}
__device__ __forceinline__ u32x4 pack8(const float (&f)[8]) {
    u32x4 w; w.x = cvt_pk_bf16(f[0], f[1]); w.y = cvt_pk_bf16(f[2], f[3]); w.z = cvt_pk_bf16(f[4], f[5]); w.w = cvt_pk_bf16(f[6], f[7]); return w;
}
__device__ __forceinline__ unsigned pack_h2(float a, float b) { h16x2 v; v.x = (_Float16)a; v.y = (_Float16)b; return __builtin_bit_cast(unsigned, v); }
__device__ __forceinline__ float h_lo(unsigned w) { return (float)__builtin_bit_cast(_Float16, (unsigned short)(w & 0xffffu)); }
__device__ __forceinline__ float h_hi(unsigned w) { return (float)__builtin_bit_cast(_Float16, (unsigned short)(w >> 16)); }
__device__ __forceinline__ void unpack8h(const u32x4 w, float (&f)[8]) {
    f[0] = h_lo(w.x); f[1] = h_hi(w.x); f[2] = h_lo(w.y); f[3] = h_hi(w.y); f[4] = h_lo(w.z); f[5] = h_hi(w.z); f[6] = h_lo(w.w); f[7] = h_hi(w.w);
}
__device__ __forceinline__ float sigmoidf_(float v) { return __builtin_amdgcn_rcpf(1.0f + __expf(-v)); }
__device__ __forceinline__ float siluf_(float v) { return v * sigmoidf_(v); }
template <int CTRL> __device__ __forceinline__ float dpp_mov(float x) {
    return __builtin_bit_cast(float, __builtin_amdgcn_mov_dpp(__builtin_bit_cast(int, x), CTRL, 0xf, 0xf, true));
}
__device__ __forceinline__ float allred8(float x) { x += dpp_mov<0xB1>(x); x += dpp_mov<0x4E>(x); x += dpp_mov<0x141>(x); return x; }
__device__ __forceinline__ float allred16(float x) { x = allred8(x); x += dpp_mov<0x128>(x); return x; }
__device__ __forceinline__ float wave_sum(float v) {
#pragma unroll
    for (int o = 1; o < 64; o <<= 1) v += __shfl_xor(v, o);
    return v;
}
__device__ __forceinline__ int prev_row(int r) { if (r >= NREAL) return r == NREAL ? -1 : r - 1; return (r & (SEQ - 1)) ? r - 1 : NROWS - 1; }

#ifndef GEMM_SP2
#define GEMM_SP2 true
#endif
#ifndef GEMM_ALIGN
#define GEMM_ALIGN true
#endif
namespace pg8 {
constexpr int BM = 256, BK = 64, HALF = 128, HTB = HALF * BK * 2, STAGE_BYTES = 8 * HTB, NXCD = 8, WGM = 4;
__host__ __device__ __forceinline__ int lds_byte(int r, int c) { const int st = (r >> 4) * 2 + (c >> 5), rr = r & 15, cc = c & 31, ob = rr * 64 + cc * 2; return st * 1024 + (ob ^ (((ob >> 9) & 1) << 5)); }
__host__ __device__ __forceinline__ void stage_rc(int b, int& R, int& C) { const int st = b / 1024, sb = b % 1024, swz = sb ^ (((sb >> 9) & 1) << 5); R = (st >> 1) * 16 + swz / 64; C = (st & 1) * 32 + (swz % 64) / 2; }
__host__ __device__ __forceinline__ int perm32(int rho) { const int n = rho >> 4, i = rho & 15; return 8 * (i >> 2) + 4 * n + (i & 3); }
struct Unit { int pm, pn; };
struct Gemm { const bf16_t* A; const bf16_t* Bt; int M, N, K; };
struct StaticOrder {
    int nM, nN, nwg, G, c;
    __device__ void init(int M, int N, int G_, int c_) { nM = M / BM; nN = N / BM; nwg = nM * nN; G = G_; c = c_; }
    __device__ bool next(int i, Unit& u) const {
        const long L = (long)i * G + c; if (L >= nwg) return false;
        int wgid = (int)L; { const int q = nwg / NXCD, r = nwg % NXCD, xcd = wgid % NXCD, off = wgid / NXCD; wgid = (xcd < r ? xcd * (q + 1) : r * (q + 1) + (xcd - r) * q) + off; }
        const int nig = WGM * nN, gid = wgid / nig, fm = gid * WGM, gsz = (nM - fm) < WGM ? (nM - fm) : WGM;
        u.pm = fm + ((wgid % nig) % gsz); u.pn = (wgid % nig) / gsz; return true;
    }
    __device__ __forceinline__ void a_ready(const Unit&) const {}
    __device__ __forceinline__ void done(const Unit&) const {}
};

template <class Epi, class Sched, bool ALIGN_EPI = false, bool SP2 = false>
__device__ __forceinline__ void gemm_phase(LAS unsigned char* lds, const Gemm g, const Sched& S, const Epi& E, const int tid) {
    const int wid = __builtin_amdgcn_readfirstlane(tid >> 6), lane = tid & 63, wr = wid >> 2, wc = wid & 3, fr = lane & 15, fq = lane >> 4;
    int K = g.K; asm volatile("" : "+s"(K)); const int nt = K / BK;
    unsigned voffA[2], voffB[2];
#pragma unroll
    for (int i = 0; i < 2; ++i) { int R, C; stage_rc(tid * 16 + i * 8192, R, C); const int Rb = Epi::PERM ? ((R & ~31) + perm32(R & 31)) : R;
        voffA[i] = (unsigned)(R * K + C) * 2u; voffB[i] = (unsigned)(Rb * K + C) * 2u; }
    const size_t kstep = (size_t)(BK * 2);
    const size_t hstep = (size_t)HALF * K * 2;
    const size_t tstep = 2 * hstep;
    const unsigned ldsw = (unsigned)wid * 1024u;
    const int aoff = lds_byte(wr * 64 + fr, fq * 8), boff = lds_byte(wc * 32 + fr, fq * 8);
#define PG8_SA(b, h) (((b) * 2 + (h)) * HTB)
#define PG8_SB(b, h) ((4 + (b) * 2 + (h)) * HTB)
#define PG8_STAGE(bufoff, gbase, voff) do { _Pragma("unroll") for (int _i = 0; _i < 2; ++_i) \
        __builtin_amdgcn_global_load_lds((const unsigned*)((const char*)(gbase) + (voff)[_i]), (LAS unsigned*)(lds + (bufoff) + ldsw + _i * 8192), 16, 0, 0); } while (0)
#define PG8_LDA(dst, b, h) do { _Pragma("unroll") for (int m = 0; m < 4; ++m) _Pragma("unroll") for (int k = 0; k < 2; ++k) dst[m][k] = *(const LAS bf16x8*)(lds + PG8_SA(b, h) + aoff + m * 2048 + k * 1024); } while (0)
#define PG8_LDB(dst, b, h) do { _Pragma("unroll") for (int n = 0; n < 2; ++n) _Pragma("unroll") for (int k = 0; k < 2; ++k) dst[n][k] = *(const LAS bf16x8*)(lds + PG8_SB(b, h) + boff + n * 2048 + k * 1024); } while (0)
#define PG8_MMA(ai, bj, At, Bt) do { __builtin_amdgcn_s_setprio(1); _Pragma("unroll") for (int m = 0; m < 4; ++m) _Pragma("unroll") for (int n = 0; n < 2; ++n) _Pragma("unroll") for (int k = 0; k < 2; ++k) \
        acc[ai][bj][m][n] = __builtin_amdgcn_mfma_f32_16x16x32_bf16(Bt[n][k], At[m][k], acc[ai][bj][m][n], 0, 0, 0); __builtin_amdgcn_s_setprio(0); } while (0)
#define PG8_WAIT_V(n) asm volatile("s_waitcnt vmcnt(" #n ")" ::: "memory")
#define PG8_WAIT_L(n) asm volatile("s_waitcnt lgkmcnt(" #n ")" ::: "memory")
#define PG8_BAR __builtin_amdgcn_s_barrier()
#define PG8_SCHED __builtin_amdgcn_sched_barrier(0)
    Unit cur, nxt; int ui = 0;
    if (!S.next(0, cur)) return;
    f32x4 acc[2][2][4][2];
#pragma unroll
    for (int a = 0; a < 2; ++a)
#pragma unroll
        for (int b = 0; b < 2; ++b)
#pragma unroll
            for (int m = 0; m < 4; ++m)
#pragma unroll
                for (int n = 0; n < 2; ++n) acc[a][b][m][n] = (f32x4){0.f, 0.f, 0.f, 0.f};
    bf16x8 At[4][2], B0[2][2], B1[2][2];
    const char* cA = (const char*)g.A + (size_t)cur.pm * tstep; const char* cB = (const char*)g.Bt + (size_t)cur.pn * tstep;
    S.a_ready(cur);
    if constexpr (SP2) {
        PG8_STAGE(PG8_SB(0, 0), cB, voffB); PG8_STAGE(PG8_SB(0, 1), cB + hstep, voffB); PG8_STAGE(PG8_SA(0, 0), cA, voffA); PG8_STAGE(PG8_SA(0, 1), cA + hstep, voffA);
        if (wr == 1) PG8_BAR;
        PG8_WAIT_V(2); PG8_BAR;
        PG8_STAGE(PG8_SB(1, 0), cB + kstep, voffB); PG8_STAGE(PG8_SA(1, 0), cA + kstep, voffA); PG8_STAGE(PG8_SB(1, 1), cB + hstep + kstep, voffB);
        PG8_WAIT_V(6); PG8_BAR;
    } else {
        PG8_STAGE(PG8_SB(0, 0), cB, voffB); PG8_STAGE(PG8_SA(0, 0), cA, voffA); PG8_STAGE(PG8_SB(0, 1), cB + hstep, voffB); PG8_STAGE(PG8_SA(0, 1), cA + hstep, voffA);
        if (wr == 1) PG8_BAR;
        PG8_WAIT_V(4); PG8_BAR;
        PG8_STAGE(PG8_SB(1, 0), cB + kstep, voffB); PG8_STAGE(PG8_SA(1, 0), cA + kstep, voffA); PG8_STAGE(PG8_SB(1, 1), cB + hstep + kstep, voffB);
        PG8_WAIT_V(6); PG8_BAR;
    }
    for (;;) {
        const bool has_next = S.next(ui + 1, nxt);
        const char* nA = has_next ? (const char*)g.A + (size_t)nxt.pm * tstep : cA; const char* nB = has_next ? (const char*)g.Bt + (size_t)nxt.pn * tstep : cB;
        for (int t = 0; t < nt; t += 2) {
            const bool last = (t == nt - 2);
            const char* a1 = cA + (size_t)(t + 1) * kstep;
            const char* a2 = last ? nA : cA + (size_t)(t + 2) * kstep; const char* b2 = last ? nB : cB + (size_t)(t + 2) * kstep;
            const char* a3 = a2 + kstep; const char* b3 = b2 + kstep;
            if (last && has_next) S.a_ready(nxt);
            if constexpr (SP2) {
            PG8_LDB(B0, 0, 0); PG8_LDB(B1, 0, 1); PG8_SCHED; PG8_LDA(At, 0, 0); PG8_STAGE(PG8_SA(1, 1), a1 + hstep, voffA);
            PG8_WAIT_V(8); PG8_WAIT_L(0); PG8_BAR; PG8_MMA(0, 0, At, B0); PG8_MMA(0, 1, At, B1); PG8_BAR; PG8_SCHED;
            PG8_LDA(At, 0, 1); PG8_STAGE(PG8_SB(0, 0), b2, voffB); PG8_STAGE(PG8_SB(0, 1), b2 + hstep, voffB); PG8_STAGE(PG8_SA(0, 0), a2, voffA);
            PG8_WAIT_V(8); PG8_WAIT_L(0); PG8_BAR; PG8_MMA(1, 0, At, B0); PG8_MMA(1, 1, At, B1); PG8_BAR; PG8_SCHED;
            PG8_LDB(B0, 1, 0); PG8_LDB(B1, 1, 1); PG8_SCHED; PG8_LDA(At, 1, 0); PG8_STAGE(PG8_SA(0, 1), a2 + hstep, voffA);
            PG8_WAIT_V(8); PG8_WAIT_L(0); PG8_BAR; PG8_MMA(0, 0, At, B0); PG8_MMA(0, 1, At, B1); PG8_BAR; PG8_SCHED;
            PG8_LDA(At, 1, 1); PG8_STAGE(PG8_SB(1, 0), b3, voffB); PG8_STAGE(PG8_SB(1, 1), b3 + hstep, voffB); PG8_STAGE(PG8_SA(1, 0), a3, voffA);
            PG8_WAIT_V(8); PG8_WAIT_L(0); PG8_BAR; PG8_MMA(1, 0, At, B0); PG8_MMA(1, 1, At, B1); PG8_BAR; PG8_SCHED;
            } else {
            PG8_LDB(B0, 0, 0); PG8_SCHED; PG8_LDA(At, 0, 0); PG8_STAGE(PG8_SA(1, 1), a1 + hstep, voffA);
            PG8_WAIT_L(8); PG8_BAR; PG8_WAIT_L(0); PG8_MMA(0, 0, At, B0); PG8_BAR; PG8_SCHED;
            PG8_LDB(B1, 0, 1); PG8_STAGE(PG8_SB(0, 0), b2, voffB);
            PG8_BAR; PG8_WAIT_L(0); PG8_MMA(0, 1, At, B1); PG8_BAR;
            PG8_LDA(At, 0, 1); PG8_STAGE(PG8_SA(0, 0), a2, voffA);
            PG8_BAR; PG8_WAIT_L(0); PG8_MMA(1, 0, At, B0); PG8_BAR; PG8_SCHED;
            PG8_STAGE(PG8_SB(0, 1), b2 + hstep, voffB);
            PG8_WAIT_V(6); PG8_BAR; PG8_MMA(1, 1, At, B1); PG8_BAR;
            PG8_LDB(B0, 1, 0); PG8_SCHED; PG8_LDA(At, 1, 0); PG8_STAGE(PG8_SA(0, 1), a2 + hstep, voffA);
            PG8_WAIT_L(8); PG8_BAR; PG8_WAIT_L(0); PG8_MMA(0, 0, At, B0); PG8_BAR; PG8_SCHED;
            PG8_LDB(B1, 1, 1); PG8_STAGE(PG8_SB(1, 0), b3, voffB);
            PG8_BAR; PG8_WAIT_L(0); PG8_MMA(0, 1, At, B1); PG8_BAR;
            PG8_LDA(At, 1, 1); PG8_STAGE(PG8_SA(1, 0), a3, voffA);
            PG8_BAR; PG8_WAIT_L(0); PG8_MMA(1, 0, At, B0); PG8_BAR; PG8_SCHED;
            PG8_STAGE(PG8_SB(1, 1), b3 + hstep, voffB);
            PG8_WAIT_V(6); PG8_BAR; PG8_MMA(1, 1, At, B1); PG8_BAR;
            }
        }
        if constexpr (ALIGN_EPI) { if (wr == 0) PG8_BAR; }
        E(acc, cur, wr, wc, fr, fq); S.done(cur);
        if (!has_next) break;
#pragma unroll
        for (int a = 0; a < 2; ++a)
#pragma unroll
            for (int b = 0; b < 2; ++b)
#pragma unroll
                for (int m = 0; m < 4; ++m)
#pragma unroll
                    for (int n = 0; n < 2; ++n) acc[a][b][m][n] = (f32x4){0.f, 0.f, 0.f, 0.f};
        cur = nxt; cA = nA; cB = nB; ++ui;
        if constexpr (ALIGN_EPI) { if (wr == 1) PG8_BAR; }
    }
    PG8_WAIT_V(0);
    if constexpr (!ALIGN_EPI) { if (wr == 0) PG8_BAR; }
    PG8_BAR;
#undef PG8_SA
#undef PG8_SB
#undef PG8_STAGE
#undef PG8_LDA
#undef PG8_LDB
#undef PG8_MMA
#undef PG8_WAIT_V
#undef PG8_WAIT_L
#undef PG8_BAR
#undef PG8_SCHED
}
template <class Epi>
__device__ __forceinline__ void gemm_run(LAS unsigned char* lds, const Gemm g, const StaticOrder& S, const Epi& E, const int tid) { gemm_phase<Epi, StaticOrder, GEMM_ALIGN, GEMM_SP2>(lds, g, S, E, tid); }
}

struct EpiP {
    static constexpr bool PERM = true;
    bf16_t* O;
    __device__ __forceinline__ void operator()(const f32x4 (&acc)[2][2][4][2], const pg8::Unit& u, int wr, int wc, int fr, int fq) const {
        const int row0 = u.pm * 256 + wr * 64 + fr, col0 = u.pn * 256 + wc * 32 + 8 * fq;
#pragma unroll
        for (int ai = 0; ai < 2; ++ai)
#pragma unroll
            for (int m = 0; m < 4; ++m) { bf16_t* rowp = O + (size_t)(row0 + ai * 128 + m * 16) * NP + col0;
#pragma unroll
                for (int bj = 0; bj < 2; ++bj) { const f32x4 v0 = acc[ai][bj][m][0], v1 = acc[ai][bj][m][1];
                    u32x4 w; w.x = cvt_pk_bf16(v0[0], v0[1]); w.y = cvt_pk_bf16(v0[2], v0[3]); w.z = cvt_pk_bf16(v1[0], v1[1]); w.w = cvt_pk_bf16(v1[2], v1[3]);
                    *(u32x4*)(rowp + bj * 128) = w; } }
    }
};
struct EpiLora {
    static constexpr bool PERM = true;
    unsigned short *X, *Ab; const float *w0, *a0;
    __device__ __forceinline__ void operator()(const f32x4 (&acc)[2][2][4][2], const pg8::Unit& u, int wr, int wc, int fr, int fq) const {
        const int row0 = u.pm * 256 + wr * 64 + fr; const int colt = u.pn * 256; const bool isA = colt >= 2048;
        unsigned short* base = isA ? Ab : X; const float* bias = isA ? a0 : w0; const float scale = isA ? 1.0f : 0.60653065971f;
        const int cc = (colt & 2047) + wc * 32 + 8 * fq;
        f32x4 bv[2][2];
#pragma unroll
        for (int bj = 0; bj < 2; ++bj) { bv[bj][0] = *(const f32x4*)(bias + cc + bj * 128); bv[bj][1] = *(const f32x4*)(bias + cc + bj * 128 + 4); }
#pragma unroll
        for (int ai = 0; ai < 2; ++ai)
#pragma unroll
            for (int m = 0; m < 4; ++m) { unsigned short* rowp = base + (size_t)(row0 + ai * 128 + m * 16) * DB + cc;
#pragma unroll
                for (int bj = 0; bj < 2; ++bj) { const f32x4 v0 = acc[ai][bj][m][0] + bv[bj][0], v1 = acc[ai][bj][m][1] + bv[bj][1];
                    u32x4 w; w.x = pack_h2(scale * sigmoidf_(v0[0]), scale * sigmoidf_(v0[1])); w.y = pack_h2(scale * sigmoidf_(v0[2]), scale * sigmoidf_(v0[3]));
                    w.z = pack_h2(scale * sigmoidf_(v1[0]), scale * sigmoidf_(v1[1])); w.w = pack_h2(scale * sigmoidf_(v1[2]), scale * sigmoidf_(v1[3]));
                    *(u32x4*)(rowp + bj * 128) = w; } }
    }
};
template <bool ACCUM> struct EpiY {
    static constexpr bool PERM = true;
    bf16_t* Mg; const bf16_t* P; int gcol;
    __device__ __forceinline__ void operator()(const f32x4 (&acc)[2][2][4][2], const pg8::Unit& u, int wr, int wc, int fr, int fq) const {
        const int row0 = u.pm * 256 + wr * 64 + fr, col0 = u.pn * 256 + wc * 32 + 8 * fq;
#pragma unroll
        for (int ai = 0; ai < 2; ++ai)
#pragma unroll
            for (int m = 0; m < 4; ++m) { const int row = row0 + ai * 128 + m * 16;
#pragma unroll
                for (int bj = 0; bj < 2; ++bj) { const int col = col0 + bj * 128;
                    const u32x4 gw = *(const u32x4*)(P + (size_t)row * NP + gcol + col);
                    float g[8], o[8]; unpack8(gw, g);
                    const f32x4 v0 = acc[ai][bj][m][0], v1 = acc[ai][bj][m][1];
#pragma unroll
                    for (int e = 0; e < 4; ++e) { o[e] = sigmoidf_(g[e]) * v0[e]; o[4 + e] = sigmoidf_(g[4 + e]) * v1[e]; }
                    bf16_t* dst = Mg + (size_t)row * D + col;
                    if (ACCUM) { const u32x4 ow = *(const u32x4*)dst; float od[8]; unpack8(ow, od);
#pragma unroll
                        for (int e = 0; e < 8; ++e) o[e] += od[e]; }
                    *(u32x4*)dst = pack8(o); } }
    }
};
struct EpiOut {
    static constexpr bool PERM = false;
    float* H;
    __device__ __forceinline__ void operator()(const f32x4 (&acc)[2][2][4][2], const pg8::Unit& u, int wr, int wc, int fr, int fq) const {
        const int row0 = u.pm * 256 + wr * 64 + fr, col0 = u.pn * 256 + wc * 32 + 4 * fq;
#pragma unroll
        for (int ai = 0; ai < 2; ++ai)
#pragma unroll
            for (int m = 0; m < 4; ++m) { float* rowp = H + (size_t)(row0 + ai * 128 + m * 16) * D + col0;
#pragma unroll
                for (int bj = 0; bj < 2; ++bj)
#pragma unroll
                    for (int n = 0; n < 2; ++n) { f32x4* ptr = (f32x4*)(rowp + bj * 128 + n * 16); *ptr = ALPHA * (*ptr) + acc[ai][bj][m][n]; } }
    }
};


template <int KS  >
__device__ __forceinline__ f32x4 meta_dot(const bf16_t* A  , const bf16_t* Bt  , int K, int ct, int k0, int fr, int fq) {
    f32x4 acc = (f32x4){0.f, 0.f, 0.f, 0.f};
    const bf16_t* ap = A + (size_t)fr * K + k0 + fq * 8; const bf16_t* bp = Bt + (size_t)(ct * 16 + fr) * K + k0 + fq * 8;
    bf16x8 a[KS / 32], b[KS / 32];
#pragma unroll
    for (int i = 0; i < KS / 32; ++i) { a[i] = *(const bf16x8*)(ap + i * 32); b[i] = *(const bf16x8*)(bp + i * 32); }
#pragma unroll
    for (int i = 0; i < KS / 32; ++i) acc = __builtin_amdgcn_mfma_f32_16x16x32_bf16(b[i], a[i], acc, 0, 0, 0);
    return acc;
}
__device__ __forceinline__ void meta_p4(const Params& P, int l, LAS unsigned char* lds, int wid, int lane) {
    if (blockIdx.x >= D / 16) return;
    const int ct = blockIdx.x, fr = lane & 15, fq = lane >> 4;
    const f32x4 ya = meta_dot<DA / 8>((const bf16_t*)(P.ws + WS_CO) + (size_t)NREAL * DA, (const bf16_t*)(P.ws + WS_WA) + (size_t)l * D * DA, DA, ct, wid * (DA / 8), fr, fq);
    const f32x4 yb = meta_dot<DB / 8>((const bf16_t*)(P.ws + WS_SB) + (size_t)NREAL * DB, (const bf16_t*)(P.ws + WS_WB) + (size_t)l * D * DB, DB, ct, wid * (DB / 8), fr, fq);
    LAS f32x4* red = (LAS f32x4*)lds;
    red[(wid * 2 + 0) * 64 + lane] = ya; red[(wid * 2 + 1) * 64 + lane] = yb;
    __syncthreads();
    if (wid == 0) {
        f32x4 sa = red[lane], sb2 = red[64 + lane];
#pragma unroll
        for (int w = 1; w < 8; ++w) { sa += red[(w * 2) * 64 + lane]; sb2 += red[(w * 2 + 1) * 64 + lane]; }
        const int row = NREAL + fr, c0 = ct * 16 + 4 * fq;
        const bf16_t* pr = (const bf16_t*)(P.ws + WS_P) + (size_t)row * NP;
        const u32x2 ga = *(const u32x2*)(pr + PC_GA + c0), gb = *(const u32x2*)(pr + PC_GB + c0);
        const float o0 = sigmoidf_(bf_lo(ga.x)) * sa[0] + sigmoidf_(bf_lo(gb.x)) * sb2[0], o1 = sigmoidf_(bf_hi(ga.x)) * sa[1] + sigmoidf_(bf_hi(gb.x)) * sb2[1];
        const float o2 = sigmoidf_(bf_lo(ga.y)) * sa[2] + sigmoidf_(bf_lo(gb.y)) * sb2[2], o3 = sigmoidf_(bf_hi(ga.y)) * sa[3] + sigmoidf_(bf_hi(gb.y)) * sb2[3];
        u32x2 w; w.x = cvt_pk_bf16(o0, o1); w.y = cvt_pk_bf16(o2, o3);
        *(u32x2*)((bf16_t*)(P.ws + WS_HB) + (size_t)row * D + c0) = w;
    }
}
__device__ __forceinline__ void meta_p5(const Params& P, int l, LAS unsigned char* lds, int wid, int lane) {
    if (blockIdx.x >= D / 16) return;
    const int ct = blockIdx.x, fr = lane & 15, fq = lane >> 4;
    const f32x4 acc = meta_dot<D / 8>((const bf16_t*)(P.ws + WS_HB) + (size_t)NREAL * D, (const bf16_t*)(P.ws + WS_WO) + (size_t)l * D * D, D, ct, wid * (D / 8), fr, fq);
    LAS f32x4* red = (LAS f32x4*)lds;
    red[wid * 64 + lane] = acc;
    __syncthreads();
    if (wid == 0) {
        f32x4 sa = red[lane];
#pragma unroll
        for (int w = 1; w < 8; ++w) sa += red[w * 64 + lane];
        f32x4* ptr = (f32x4*)((float*)(P.ws + WS_HF) + (size_t)(NREAL + fr) * D + ct * 16 + 4 * fq);
        *ptr = ALPHA * (*ptr) + sa;
    }
}

__device__ __forceinline__ void transpose_item(const float* W, int ldw, int src_n0, int k0, bf16_t* WT, int K, int dst_n0, LAS float* scr, int lane) {
    if (src_n0 >= 0) {
        f32x4 v[8]; const int n4 = (lane & 7) * 4;
#pragma unroll
        for (int i = 0; i < 8; ++i) v[i] = *(const f32x4*)(W + (size_t)(k0 + (lane >> 3) + 8 * i) * ldw + src_n0 + n4);
#pragma unroll
        for (int i = 0; i < 8; ++i) { LAS float* d = scr + ((lane >> 3) + 8 * i) * 33 + n4; d[0] = v[i].x; d[1] = v[i].y; d[2] = v[i].z; d[3] = v[i].w; }
    }
    asm volatile("s_waitcnt lgkmcnt(0)" ::: "memory");
    const int c = lane & 7;
#pragma unroll
    for (int j = 0; j < 4; ++j) { const int n = (lane >> 3) + 8 * j; const LAS float* s = scr + (8 * c) * 33 + n;
        u32x4 o = (u32x4){0u, 0u, 0u, 0u};
        if (src_n0 >= 0) { o.x = cvt_pk_bf16(s[0 * 33], s[1 * 33]); o.y = cvt_pk_bf16(s[2 * 33], s[3 * 33]); o.z = cvt_pk_bf16(s[4 * 33], s[5 * 33]); o.w = cvt_pk_bf16(s[6 * 33], s[7 * 33]); }
        *(u32x4*)(WT + (size_t)(dst_n0 + n) * K + k0 + 8 * c) = o; }
    asm volatile("s_waitcnt lgkmcnt(0)" ::: "memory");
}
__device__ __forceinline__ int win_src_col(int j) { return j < 12288 ? j : (j < 16384 ? j + 192 : (j < 16576 ? j - 4096 : -1)); }

__device__ __forceinline__ void convert_win(const Params& P, int l, LAS unsigned char* lds, int gw, int ngw, int wid, int lane) {
    LAS float* scr = (LAS float*)(lds + wid * 8448);
    const float* W = P.w_in + (size_t)l * D * NCOLS; bf16_t* WT = (bf16_t*)(P.ws + WS_WIN);
    constexpr int NBLK = NP / 32;
    for (int it = gw; it < (D / 64) * NBLK; it += ngw) { const int kb = it / NBLK, nb = it % NBLK;
        transpose_item(W, NCOLS, win_src_col(nb * 32), kb * 64, WT, D, nb * 32, scr, lane); }
}
__device__ __forceinline__ void convert_small(const Params& P, LAS unsigned char* lds, int gw, int ngw, int wid, int lane) {
    LAS float* scr = (LAS float*)(lds + wid * 8448);
    constexpr int IA = (DA / 64) * (D / 32), IB = (DB / 64) * (D / 32), IO = (D / 64) * (D / 32), IL = IA + IB + IO;
    for (int it = gw; it < DEPTH * IL; it += ngw) { const int l = it / IL; int r = it % IL;
        if (r < IA) { transpose_item(P.w_a + (size_t)l * DA * D, D, (r % (D / 32)) * 32, (r / (D / 32)) * 64, (bf16_t*)(P.ws + WS_WA) + (size_t)l * D * DA, DA, (r % (D / 32)) * 32, scr, lane); continue; } r -= IA;
        if (r < IB) { transpose_item(P.w_b + (size_t)l * DB * D, D, (r % (D / 32)) * 32, (r / (D / 32)) * 64, (bf16_t*)(P.ws + WS_WB) + (size_t)l * D * DB, DB, (r % (D / 32)) * 32, scr, lane); continue; } r -= IB;
        transpose_item(P.w_out + (size_t)l * D * D, D, (r % (D / 32)) * 32, (r / (D / 32)) * 64, (bf16_t*)(P.ws + WS_WO) + (size_t)l * D * D, D, (r % (D / 32)) * 32, scr, lane); }
    bf16_t* WL = (bf16_t*)(P.ws + WS_WL);
    const size_t tot = (size_t)DEPTH * 4096 * 32;
    for (size_t it = (size_t)gw * 64 + lane; it < tot; it += (size_t)ngw * 64) {
        const int n = (int)(it % 4096); const int kc = (int)((it / 4096) % 32) * 8; const int l = (int)(it / (4096 * 32));
        float f[8];
#pragma unroll
        for (int e = 0; e < 8; ++e) { const int k = kc + e; float v = 0.f;
            if (n < 2048) { if (k < LORA) v = P.w2[((size_t)l * LORA + k) * DB + n]; }
            else { if (k >= 128 && k < 128 + LORA) v = P.a2[((size_t)l * LORA + (k - 128)) * DB + (n - 2048)]; }
            f[e] = v; }
        *(u32x4*)(WL + ((size_t)l * 4096 + n) * 256 + kc) = pack8(f);
    }
}
__device__ __forceinline__ void ln_row(const float* src, const float* g, const float* b, float* dstf, bf16_t* dstb, int lane) {
    const f32x4* xr = (const f32x4*)src + lane;
    f32x4 v[8]; float s = 0.f;
#pragma unroll
    for (int j = 0; j < 8; ++j) { v[j] = xr[64 * j]; s += (v[j].x + v[j].y) + (v[j].z + v[j].w); }
    const float mean = wave_sum(s) * (1.f / D); float s2 = 0.f;
#pragma unroll
    for (int j = 0; j < 8; ++j) { v[j] = v[j] - mean; s2 += (v[j].x * v[j].x + v[j].y * v[j].y) + (v[j].z * v[j].z + v[j].w * v[j].w); }
    const float rstd = 1.f / sqrtf(wave_sum(s2) * (1.f / D) + LN_EPS);
#pragma unroll
    for (int j = 0; j < 8; ++j) { const f32x4 gg = ((const f32x4*)g)[lane + 64 * j], bb = ((const f32x4*)b)[lane + 64 * j];
        const f32x4 o = v[j] * rstd * gg + bb;
        if (dstf) ((f32x4*)dstf)[lane + 64 * j] = o;
        if (dstb) { u32x2 w; w.x = cvt_pk_bf16(o.x, o.y); w.y = cvt_pk_bf16(o.z, o.w); ((u32x2*)dstb)[lane + 64 * j] = w; } }
}
__device__ __forceinline__ void embed_phase(const Params& P, int gw, int ngw, int lane) {
    float* hf = (float*)(P.ws + WS_HF); bf16_t* hb = (bf16_t*)(P.ws + WS_HB);
    for (int r = gw; r < MPAD; r += ngw) {
        if (r < NROWS) { const float* src = r < NREAL ? P.x + (size_t)r * D : P.meta + (size_t)(r - NREAL) * D;
            ln_row(src, P.emb_g, P.emb_b, hf + (size_t)r * D, hb + (size_t)r * D, lane); }
        else {
#pragma unroll
            for (int j = 0; j < 8; ++j) { ((f32x4*)(hf + (size_t)r * D))[lane + 64 * j] = (f32x4){0.f, 0.f, 0.f, 0.f}; ((u32x2*)(hb + (size_t)r * D))[lane + 64 * j] = (u32x2){0u, 0u}; }
        }
    }
}
__device__ __forceinline__ void ln_phase(const Params& P, int l, int gw, int ngw, int lane) {
    float* hf = (float*)(P.ws + WS_HF); bf16_t* hb = (bf16_t*)(P.ws + WS_HB);
    const float* g = P.ln_g + (size_t)l * D; const float* b = P.ln_b + (size_t)l * D;
    if (l == DEPTH - 1) { for (int r = gw; r < NREAL; r += ngw) ln_row(hf + (size_t)r * D, g, b, P.out + (size_t)r * D, nullptr, lane); }
    else { for (int r = gw; r < NROWS; r += ngw) ln_row(hf + (size_t)r * D, g, b, hf + (size_t)r * D, hb + (size_t)r * D, lane); }
}

constexpr int RUN = 8, NRUN = NROWS / RUN;
__device__ __forceinline__ void p2_phase(const Params& P, int l, size_t gtid, size_t gthreads) {
    const bf16_t* p = (const bf16_t*)(P.ws + WS_P); bf16_t* co = (bf16_t*)(P.ws + WS_CO); bf16_t* al = (bf16_t*)(P.ws + WS_AL);
    const float* cw = P.conv_w + (size_t)l * 3 * DA; const float* mu = P.mu + (size_t)l * 8384;
    const size_t tot = (size_t)NRUN * 160;
    for (size_t it = gtid; it < tot; it += gthreads) {
        const int run = (int)(it / 160), ch = (int)(it % 160); const int row0 = run * RUN;
        const int r1 = prev_row(row0), r2 = r1 >= 0 ? prev_row(r1) : -1;
        if (ch < 128) {
            const int c0 = ch * 8;
            float w0[8], w1[8], w2[8], u1[8], u2[8], xa[8], xb[8];
#pragma unroll
            for (int e = 0; e < 8; ++e) { w0[e] = cw[c0 + e]; w1[e] = cw[DA + c0 + e]; w2[e] = cw[2 * DA + c0 + e]; u1[e] = 0.f; u2[e] = 0.f; }
            if (r1 >= 0) { const bf16_t* q = p + (size_t)r1 * NP; unpack8(*(const u32x4*)(q + PC_XIN + c0), xa); unpack8(*(const u32x4*)(q + PC_CG + c0), xb);
#pragma unroll
                for (int e = 0; e < 8; ++e) u1[e] = xa[e] * xb[e]; }
            if (r2 >= 0) { const bf16_t* q = p + (size_t)r2 * NP; unpack8(*(const u32x4*)(q + PC_XIN + c0), xa); unpack8(*(const u32x4*)(q + PC_CG + c0), xb);
#pragma unroll
                for (int e = 0; e < 8; ++e) u2[e] = xa[e] * xb[e]; }
            u32x4 Lx[RUN], Lc[RUN], Lb[RUN], Lz[RUN];
#pragma unroll
            for (int rr = 0; rr < RUN; ++rr) { const bf16_t* pr = p + (size_t)(row0 + rr) * NP + c0; Lx[rr] = *(const u32x4*)(pr + PC_XIN); Lc[rr] = *(const u32x4*)(pr + PC_CG); Lb[rr] = *(const u32x4*)(pr + PC_BG); Lz[rr] = *(const u32x4*)(pr + PC_ZA); }
#pragma unroll
            for (int rr = 0; rr < RUN; ++rr) {
                float bg[8], z[8], o[8], u0[8]; unpack8(Lx[rr], xa); unpack8(Lc[rr], xb); unpack8(Lb[rr], bg); unpack8(Lz[rr], z);
#pragma unroll
                for (int e = 0; e < 8; ++e) { u0[e] = xa[e] * xb[e]; const float cv = w0[e] * u2[e] + w1[e] * u1[e] + w2[e] * u0[e]; o[e] = bg[e] * cv * siluf_(z[e]); u2[e] = u1[e]; u1[e] = u0[e]; }
                *(u32x4*)(co + (size_t)(row0 + rr) * DA + c0) = pack8(o);
            }
        } else {
            const int kc = (ch - 128) * 8;
            const bool isw = kc < LORA, isa = (kc >= 128 && kc < 128 + LORA);
            if (isw || isa) {
                const int pc = isw ? PC_WLO + kc : PC_ALO + (kc - 128); const int mi = isw ? 8192 + kc : 8288 + (kc - 128);
                float m[8], q[8], c[8], o[8];
#pragma unroll
                for (int e = 0; e < 8; ++e) { m[e] = mu[mi + e]; q[e] = 0.f; }
                if (r1 >= 0) unpack8(*(const u32x4*)(p + (size_t)r1 * NP + pc), q);
                u32x4 Lc[RUN];
#pragma unroll
                for (int rr = 0; rr < RUN; ++rr) Lc[rr] = *(const u32x4*)(p + (size_t)(row0 + rr) * NP + pc);
#pragma unroll
                for (int rr = 0; rr < RUN; ++rr) { unpack8(Lc[rr], c);
#pragma unroll
                    for (int e = 0; e < 8; ++e) { const float v = c[e] + m[e] * (q[e] - c[e]); o[e] = isw ? tanhf(v) : v; q[e] = c[e]; }
                    *(u32x4*)(al + (size_t)(row0 + rr) * 256 + kc) = pack8(o); }
            } else {
#pragma unroll
                for (int rr = 0; rr < RUN; ++rr) *(u32x4*)(al + (size_t)(row0 + rr) * 256 + kc) = (u32x4){0u, 0u, 0u, 0u};
            }
        }
    }
}

constexpr int TC = 32, NCH = 1 + SEQ / TC;
constexpr int REC = 1280;
constexpr int SC_OPND = 0, SC_V = TC * REC, SC_Y = SC_V + TC * 16 * 8, SC_BUF = SC_Y + TC * 16 * 4;
#define SCAN_BARRIER() do { asm volatile("s_waitcnt lgkmcnt(0)" ::: "memory"); __builtin_amdgcn_s_barrier(); asm volatile("" ::: "memory"); } while (0)
__device__ __forceinline__ void scan_phase(const Params& P, int l, LAS unsigned char* lds, const int tid) {
    const int wid = __builtin_amdgcn_readfirstlane(tid >> 6), lane = tid & 63;
    const bf16_t* p = (const bf16_t*)(P.ws + WS_P); const unsigned short* xb = (const unsigned short*)(P.ws + WS_HB); const unsigned short* ab = (const unsigned short*)(P.ws + WS_AB);
    bf16_t* sb = (bf16_t*)(P.ws + WS_SB); float* bon = (float*)(P.ws + WS_BON);
    for (int item = blockIdx.x; item < 256; item += gridDim.x) {
        const int xcd_ = item & 7, y_ = item >> 3, hh_ = xcd_ * 8 + (y_ >> 2);
        const int b = hh_ >> 5, h = hh_ & 31, q = y_ & 3;
        const int j = tid & 255, tt = j >> 3, cgp = j & 7, c0 = h * 64 + cgp * 8;
        const bool vown = (cgp >> 1) == q;
        u32x4 LAr0, LAr1, LAk0, LAk1, LAx, LAa, LBr0, LBr1, LBk0, LBk1, LBx, LBa; unsigned LAv0 = 0u, LAv1 = 0u, LBv0 = 0u, LBv1 = 0u;
        LAr0 = LAr1 = LAk0 = LAk1 = LAx = LAa = LBr0 = LBr1 = LBk0 = LBk1 = LBx = LBa = (u32x4){0u, 0u, 0u, 0u};
        const int cv = h * 64 + q * 16 + 2 * cgp;
        const int rl = lane >> 4, kq = lane & 15, rowl = (wid & 3) * 4 + rl;
        f32x2 s01 = (f32x2){0.f, 0.f}, s23 = (f32x2){0.f, 0.f}; float yacc = 0.f;
#define CHUNK_ROW(c, t) ((c) == 0 ? NREAL + (t) : b * SEQ + ((c) - 1) * TC + (t))
#define ISSUE_LOADS(L, c) do { const bool valid_ = ((c) > 0) || (tt < NMETA); if (valid_) { const int row_ = CHUNK_ROW(c, tt); const int pr_ = prev_row(row_); \
            const bf16_t* a_ = p + (size_t)row_ * NP + c0; L##r0 = *(const u32x4*)(a_ + PC_R); L##k0 = *(const u32x4*)(a_ + PC_K); L##v0 = *(const unsigned*)(p + (size_t)row_ * NP + PC_V + cv); \
            L##x = *(const u32x4*)(xb + (size_t)row_ * DB + c0); L##a = *(const u32x4*)(ab + (size_t)row_ * DB + c0); \
            if (pr_ >= 0) { const bf16_t* a1_ = p + (size_t)pr_ * NP + c0; L##r1 = *(const u32x4*)(a1_ + PC_R); L##k1 = *(const u32x4*)(a1_ + PC_K); L##v1 = *(const unsigned*)(p + (size_t)pr_ * NP + PC_V + cv); } \
            else { L##r1 = L##k1 = (u32x4){0u, 0u, 0u, 0u}; L##v1 = 0u; } } } while (0)
        if (wid >= 4) {
            if (j < 96) {
                const float* mu = P.mu + (size_t)l * 8384; const int arr = j >> 4, c4 = h * 64 + (j & 15) * 4;
                const float* src = arr == 0 ? mu + c4 : arr == 1 ? mu + 2048 + c4 : arr == 2 ? mu + 4096 + c4 : arr == 3 ? P.kks + (size_t)l * DB + c4 : arr == 4 ? P.kas + (size_t)l * DB + c4 : P.rk + (size_t)l * DB + c4;
                ((LAS f32x4*)(lds + 2 * SC_BUF))[j] = *(const f32x4*)src;
            }
            ISSUE_LOADS(LA, 0); ISSUE_LOADS(LB, 1);
        } else {
            __builtin_amdgcn_s_setprio(2);
        }
        __syncthreads();
        float mur[8], muk[8], kks[8], kas[8], rks[8]; const float muva = P.mu[(size_t)l * 8384 + 4096 + cv], muvb = P.mu[(size_t)l * 8384 + 4096 + cv + 1];
        { LAS const f32x4* cst_ = (LAS const f32x4*)(lds + 2 * SC_BUF) + cgp * 2;
#pragma unroll
          for (int e = 0; e < 4; ++e) { mur[e] = cst_[0][e]; mur[4 + e] = cst_[1][e]; muk[e] = cst_[16][e]; muk[4 + e] = cst_[17][e]; kks[e] = cst_[48][e]; kks[4 + e] = cst_[49][e];
              kas[e] = cst_[64][e]; kas[4 + e] = cst_[65][e]; rks[e] = cst_[80][e]; rks[4 + e] = cst_[81][e]; } }
#define SCAN_ITER(L, i) do { \
            if (wid >= 4) { \
                if ((i) >= 2 && (i) - 2 < NCH) {     \
                    const int c = (i) - 2; const bool valid = (c > 0) ? true : (tt < NMETA && b == 0); \
                    if (valid) { const LAS f32x2* yb = (const LAS f32x2*)(lds + ((i) & 1) * SC_BUF + SC_Y + tt * 64) + cgp; const f32x2 y = *yb; \
                        const f32x4 vc_ = *((const LAS f32x4*)(lds + ((i) & 1) * SC_BUF + SC_V + tt * 128) + cgp); \
                        *(unsigned*)(sb + (size_t)CHUNK_ROW(c, tt) * DB + h * 64 + q * 16 + 2 * cgp) = cvt_pk_bf16(y.x + vc_.y, y.y + vc_.w); } \
                } \
                if ((i) < NCH) { \
                    LAS unsigned char* buf = lds + ((i) & 1) * SC_BUF; \
                    const bool valid = ((i) > 0) || (tt < NMETA); \
                    float r0[8], r1[8], k0[8], k1[8], xx[8], aa[8]; \
                    unpack8(L##r0, r0); unpack8(L##r1, r1); unpack8(L##k0, k0); unpack8(L##k1, k1); unpack8h(L##x, xx); unpack8h(L##a, aa); \
                    float rr[8], kp[8], kkv[8], dec[8]; float ss = 0.f; \
                    _Pragma("unroll") for (int e = 0; e < 8; ++e) { rr[e] = r0[e] + mur[e] * (r1[e] - r0[e]); kp[e] = k0[e] + muk[e] * (k1[e] - k0[e]); dec[e] = __expf(-xx[e]); \
                        kkv[e] = kp[e] * kks[e]; ss += kkv[e] * kkv[e]; } \
                    ss = allred8(ss); \
                    const float inv = __builtin_amdgcn_rsqf(fmaxf(ss, 1e-24f)); \
                    float kk[8], kka[8], kt[8], wr[8]; float bs = 0.f, c1 = 0.f, c2 = 0.f; \
                    _Pragma("unroll") for (int e = 0; e < 8; ++e) { kk[e] = kkv[e] * inv; kka[e] = kk[e] * aa[e]; kt[e] = kp[e] * (1.0f + (aa[e] - 1.0f) * kas[e]); bs += rr[e] * kt[e] * rks[e]; \
                        wr[e] = dec[e] * rr[e]; c1 += kka[e] * rr[e]; c2 += kt[e] * rr[e]; } \
                    bs = allred8(bs); c1 = allred8(c1); c2 = allred8(c2); \
                    if (valid) { \
                        LAS f32x4* o = (LAS f32x4*)(buf + SC_OPND + tt * REC) + cgp;     \
                        float rp[8]; _Pragma("unroll") for (int e = 0; e < 8; ++e) rp[e] = wr[e] - c1 * kk[e]; \
                        o[0] = (f32x4){kk[0], rp[0], kk[1], rp[1]}; o[8] = (f32x4){kk[4], rp[4], kk[5], rp[5]}; \
                        o[16] = (f32x4){kk[2], rp[2], kk[3], rp[3]}; o[24] = (f32x4){kk[6], rp[6], kk[7], rp[7]}; \
                        o[32] = (f32x4){dec[0], dec[1], dec[2], dec[3]}; o[40] = (f32x4){dec[4], dec[5], dec[6], dec[7]}; \
                        o[48] = (f32x4){kka[0], kka[1], kka[2], kka[3]}; o[56] = (f32x4){kka[4], kka[5], kka[6], kka[7]}; \
                        o[64] = (f32x4){kt[0], kt[1], kt[2], kt[3]}; o[72] = (f32x4){kt[4], kt[5], kt[6], kt[7]}; \
                        { const float v0a_ = bf_lo(L##v0), v0b_ = bf_hi(L##v0), v1a_ = bf_lo(L##v1), v1b_ = bf_hi(L##v1); \
                          const float vva_ = v0a_ + muva * (v1a_ - v0a_), vvb_ = v0b_ + muvb * (v1b_ - v0b_); \
                          *((LAS f32x4*)(buf + SC_V + tt * 128) + cgp) = (f32x4){vva_, vva_ * c2, vvb_, vvb_ * c2}; }     \
                        if (q == 0 && cgp == 0 && ((i) > 0 || b == 0)) bon[(size_t)CHUNK_ROW(i, tt) * 32 + h] = bs; \
                    } \
                } \
                if ((i) + 2 < NCH) ISSUE_LOADS(L, (i) + 2); \
            } else { \
                if ((i) >= 1 && (i) <= NCH) { \
                    const int c = (i) - 1; const int ntok = c == 0 ? NMETA : TC; \
                    LAS const unsigned char* buf = lds + (c & 1) * SC_BUF; \
                    LAS float* ybuf = (LAS float*)(lds + (c & 1) * SC_BUF + SC_Y) + (15 - kq) * 16 + rowl; \
                    f32x4 Akra, Akrb, Aw, Aka, Ak, Bkra, Bkrb, Bw, Bka, Bk; f32x2 Av, Bv; \
                    LAS const unsigned char* ob = buf + SC_OPND + ((kq >> 1) + 8 * (kq & 1)) * 16; LAS const unsigned char* vb = buf + SC_V + rowl * 8; \
                    LOADOPS(A, 0); \
                    _Pragma("unroll 1") for (int g = 0; g < ntok; g += 16) { \
                        asm volatile("" : "+v"(ob), "+v"(vb));     \
                        _Pragma("unroll") for (int u = 0; u < 8; ++u) { LOADOPS(B, 2 * u + 1); STEP(A); LOADOPS(A, 2 * u + 2); STEP(B); } \
                        ob += 16 * REC; vb += 16 * 128; \
                        ybuf[g * 16] = yacc; } \
                } \
            } \
            SCAN_BARRIER(); } while (0)
#define LOADOPS(S, t) do { S##kra = *(LAS const f32x4*)(ob + (t) * REC); S##krb = *(LAS const f32x4*)(ob + (t) * REC + 256); S##w = *(LAS const f32x4*)(ob + (t) * REC + 512); \
                        S##ka = *(LAS const f32x4*)(ob + (t) * REC + 768); S##k = *(LAS const f32x4*)(ob + (t) * REC + 1024); S##v = *(LAS const f32x2*)(vb + (t) * 128); } while (0)
#define LO2(v) __builtin_shufflevector(v, v, 0, 1)
#define HI2(v) __builtin_shufflevector(v, v, 2, 3)
#define STEP(S) do { \
                        f32x2 P_ = (f32x2){s01.x, s01.x} * LO2(S##kra); \
                        P_ = (f32x2){s01.y, s01.y} * HI2(S##kra) + P_; \
                        P_ = (f32x2){s23.x, s23.x} * LO2(S##krb) + P_; \
                        P_ = (f32x2){s23.y, s23.y} * HI2(S##krb) + P_; \
                        float sa_ = P_.x, yp_ = P_.y; \
                        f32x2 m01_ = s01 * LO2(S##w), m23_ = s23 * HI2(S##w); \
                        sa_ += dpp_mov<0xB1>(sa_); yp_ += dpp_mov<0xB1>(yp_); \
                        m01_ = (f32x2){S##v.x, S##v.x} * LO2(S##k) + m01_; \
                        sa_ += dpp_mov<0x4E>(sa_); yp_ += dpp_mov<0x4E>(yp_); \
                        m23_ = (f32x2){S##v.x, S##v.x} * HI2(S##k) + m23_; \
                        sa_ += dpp_mov<0x141>(sa_); yp_ += dpp_mov<0x141>(yp_); sa_ += dpp_mov<0x128>(sa_); yp_ += dpp_mov<0x128>(yp_); \
                        const f32x2 sa2_ = (f32x2){sa_, sa_}; \
                        s01 = m01_ - sa2_ * LO2(S##ka); s23 = m23_ - sa2_ * HI2(S##ka); \
                        yacc = __builtin_bit_cast(float, __builtin_amdgcn_update_dpp(__builtin_bit_cast(int, yp_), __builtin_bit_cast(int, yacc), 0x111, 0xf, 0xf, false)); } while (0)
#pragma unroll 1
        for (int i = 0; i < NCH + 2; i += 2) { SCAN_ITER(LA, i); SCAN_ITER(LB, i + 1); }
        if (wid < 4) __builtin_amdgcn_s_setprio(0);
        __syncthreads();
    }
}

__device__ __forceinline__ void p3b_phase(const Params& P, int l, size_t gtid, size_t gthreads) {
    const bf16_t* p = (const bf16_t*)(P.ws + WS_P); bf16_t* sb = (bf16_t*)(P.ws + WS_SB); const float* bon = (const float*)(P.ws + WS_BON);
    const float* mu = P.mu + (size_t)l * 8384; const float* gg = P.gn_g + (size_t)l * DB; const float* gb = P.gn_b + (size_t)l * DB;
    const size_t tot = (size_t)NRUN * 256;
    for (size_t it = gtid; it < tot; it += gthreads) {
        const int run = (int)(it >> 8), h = (int)((it >> 3) & 31), c0 = h * 64 + (int)(it & 7) * 8; const int row0 = run * RUN; const int r1 = prev_row(row0);
        float mv[8], mz[8], g8[8], b8[8], v1[8], z1[8];
#pragma unroll
        for (int e = 0; e < 8; ++e) { mv[e] = mu[4096 + c0 + e]; mz[e] = mu[6144 + c0 + e]; g8[e] = gg[c0 + e]; b8[e] = gb[c0 + e]; v1[e] = 0.f; z1[e] = 0.f; }
        if (r1 >= 0) { unpack8(*(const u32x4*)(p + (size_t)r1 * NP + PC_V + c0), v1); unpack8(*(const u32x4*)(p + (size_t)r1 * NP + PC_Z + c0), z1); }
        u32x4 Ly[RUN], Lv[RUN], Lz[RUN]; float Lb[RUN];
#pragma unroll
        for (int rr = 0; rr < RUN; ++rr) { const size_t row = (size_t)(row0 + rr); Ly[rr] = *(const u32x4*)(sb + row * DB + c0); Lv[rr] = *(const u32x4*)(p + row * NP + PC_V + c0); Lz[rr] = *(const u32x4*)(p + row * NP + PC_Z + c0); Lb[rr] = bon[row * 32 + h]; }
#pragma unroll
        for (int rr = 0; rr < RUN; ++rr) {
            float y[8], v0[8], z0[8], o[8]; unpack8(Ly[rr], y); unpack8(Lv[rr], v0); unpack8(Lz[rr], z0);
            float s1 = 0.f;
#pragma unroll
            for (int e = 0; e < 8; ++e) s1 += y[e];
            const float mean = allred8(s1) * (1.f / 64.f); float s2 = 0.f;
#pragma unroll
            for (int e = 0; e < 8; ++e) { y[e] -= mean; s2 += y[e] * y[e]; }
            const float rstd = __builtin_amdgcn_rsqf(allred8(s2) * (1.f / 64.f) + GN_EPS); const float bs = Lb[rr];
#pragma unroll
            for (int e = 0; e < 8; ++e) { const float vp = v0[e] + mv[e] * (v1[e] - v0[e]); const float zp = z0[e] + mz[e] * (z1[e] - z0[e]);
                o[e] = (y[e] * rstd * g8[e] + b8[e] + bs * vp) * siluf_(zp); v1[e] = v0[e]; z1[e] = z0[e]; }
            *(u32x4*)(sb + (size_t)(row0 + rr) * DB + c0) = pack8(o);
        }
    }
}

constexpr size_t WS_DBG = WS_END;
__device__ __forceinline__ void dbg_fail(const Params& P, unsigned bit) { atomicOr((unsigned*)(P.ws + WS_DBG), bit); }
__device__ __forceinline__ float bf2f(bf16_t v) { return __uint_as_float((unsigned)v << 16); }
__device__ __forceinline__ float h2f(unsigned short v) { return (float)__builtin_bit_cast(_Float16, v); }
__device__ __forceinline__ void chk_gemm1(const Params& P, int gw, int ngw, int lane) {
    const bf16_t* hb = (const bf16_t*)(P.ws + WS_HB); const bf16_t* wt = (const bf16_t*)(P.ws + WS_WIN); const bf16_t* p = (const bf16_t*)(P.ws + WS_P);
    for (int i = gw; i < 4096; i += ngw) { const int row = (int)(((long)i * 977) % NROWS), col = (int)(((long)i * 613) % NP);
        float s = 0.f; for (int k = lane; k < D; k += 64) s += bf2f(hb[(size_t)row * D + k]) * bf2f(wt[(size_t)col * D + k]);
        s = wave_sum(s); const float got = bf2f(p[(size_t)row * NP + col]);
        if (lane == 0 && !(fabsf(got - s) <= 0.03f + 0.02f * fabsf(s))) dbg_fail(P, 1u); }
}
__device__ __forceinline__ void chk_lora(const Params& P, int l, int gw, int ngw, int lane) {
    const bf16_t* al = (const bf16_t*)(P.ws + WS_AL); const bf16_t* wl = (const bf16_t*)(P.ws + WS_WL) + (size_t)l * 4096 * 256;
    const unsigned short* xb = (const unsigned short*)(P.ws + WS_HB); const unsigned short* ab = (const unsigned short*)(P.ws + WS_AB);
    for (int i = gw; i < 4096; i += ngw) { const int row = (int)(((long)i * 977) % NROWS), c = (int)(((long)i * 613) % DB);
        float s1 = 0.f, s2 = 0.f; for (int k = lane; k < 256; k += 64) { const float av = bf2f(al[(size_t)row * 256 + k]); s1 += av * bf2f(wl[(size_t)c * 256 + k]); s2 += av * bf2f(wl[(size_t)(2048 + c) * 256 + k]); }
        s1 = wave_sum(s1); s2 = wave_sum(s2);
        const float xr = 0.60653065971f / (1.f + expf(-(P.w0[(size_t)l * DB + c] + s1))), ar = 1.f / (1.f + expf(-(P.a0[(size_t)l * DB + c] + s2)));
        const float xg = h2f(xb[(size_t)row * DB + c]), ag = h2f(ab[(size_t)row * DB + c]);
        if (lane == 0 && !(fabsf(xg - xr) <= 1e-4f + 0.01f * fabsf(xr))) dbg_fail(P, 2u);
        if (lane == 0 && !(fabsf(ag - ar) <= 1e-3f + 0.01f * fabsf(ar))) dbg_fail(P, 4u); }
}
__device__ __forceinline__ void chk_scan(const Params& P, int l, LAS unsigned char* lds, int gw, int wid, int lane) {
    if (gw >= 8) return;
    const int b = gw & 1, h = (gw * 5 + 3) & 31;
    LAS float* S = (LAS float*)(lds + wid * 16384); LAS float* op = S + 64 * 49;
    const bf16_t* p = (const bf16_t*)(P.ws + WS_P); const unsigned short* xb = (const unsigned short*)(P.ws + WS_HB); const unsigned short* ab = (const unsigned short*)(P.ws + WS_AB);
    const bf16_t* sb = (const bf16_t*)(P.ws + WS_SB); const float* bon = (const float*)(P.ws + WS_BON);
    const float* mu = P.mu + (size_t)l * 8384; const int c = h * 64 + lane;
    (void)S; (void)op;
    LAS float* st = S + lane * 64;
    for (int k = 0; k < 64; ++k) st[(k + lane) & 63] = 0.f;
    const float mur = mu[c], muk = mu[2048 + c], muv = mu[4096 + c], kks = P.kks[(size_t)l * DB + c], kas = P.kas[(size_t)l * DB + c], rks = P.rk[(size_t)l * DB + c];
    for (int tau = 0; tau < 16 + 40; ++tau) {
        const int row = tau < 16 ? NREAL + tau : b * SEQ + (tau - 16); const int pr = prev_row(row);
        const float r0 = bf2f(p[(size_t)row * NP + PC_R + c]), k0 = bf2f(p[(size_t)row * NP + PC_K + c]), v0 = bf2f(p[(size_t)row * NP + PC_V + c]);
        const float r1 = pr >= 0 ? bf2f(p[(size_t)pr * NP + PC_R + c]) : 0.f, k1 = pr >= 0 ? bf2f(p[(size_t)pr * NP + PC_K + c]) : 0.f, v1 = pr >= 0 ? bf2f(p[(size_t)pr * NP + PC_V + c]) : 0.f;
        const float rr = r0 + mur * (r1 - r0), kp = k0 + muk * (k1 - k0), vp = v0 + muv * (v1 - v0);
        const float x = h2f(xb[(size_t)row * DB + c]), a = h2f(ab[(size_t)row * DB + c]);
        const float w = expf(-x); const float kkv = kp * kks; const float nrm = sqrtf(wave_sum(kkv * kkv)); const float kk = kkv / fmaxf(nrm, 1e-12f);
        const float kka = kk * a, kt = kp * (1.f + (a - 1.f) * kas);
        const float bs = wave_sum(rr * kt * rks);
        float sa = 0.f;
#pragma unroll 1
        for (int k = 0; k < 64; ++k) sa += st[(k + lane) & 63] * __shfl(kk, k);
        float y = 0.f;
#pragma unroll 1
        for (int k = 0; k < 64; ++k) { const float nv = st[(k + lane) & 63] * __shfl(w, k) - sa * __shfl(kka, k) + vp * __shfl(kt, k); st[(k + lane) & 63] = nv; y += nv * __shfl(rr, k); }
        if (tau >= 16 || b == 0) {
            const float yg = bf2f(sb[(size_t)row * DB + c]);
            if (!(fabsf(yg - y) <= 0.02f + 0.02f * fabsf(y))) dbg_fail(P, 8u);
            if (lane == 0 && !(fabsf(bon[(size_t)row * 32 + h] - bs) <= 1e-3f + 1e-3f * fabsf(bs))) dbg_fail(P, 16u);
        }
    }
}
__device__ __forceinline__ void chk_merged(const Params& P, int l, int gw, int ngw, int lane) {
    const bf16_t* co = (const bf16_t*)(P.ws + WS_CO); const bf16_t* sb = (const bf16_t*)(P.ws + WS_SB); const bf16_t* p = (const bf16_t*)(P.ws + WS_P); const bf16_t* mg = (const bf16_t*)(P.ws + WS_HB);
    const bf16_t* wa = (const bf16_t*)(P.ws + WS_WA) + (size_t)l * D * DA; const bf16_t* wb = (const bf16_t*)(P.ws + WS_WB) + (size_t)l * D * DB;
    for (int i = gw; i < 4096; i += ngw) { const int row = (int)(((long)i * 977) % NROWS), c = (int)(((long)i * 613) % D);
        float s1 = 0.f, s2 = 0.f; for (int k = lane; k < DA; k += 64) s1 += bf2f(co[(size_t)row * DA + k]) * bf2f(wa[(size_t)c * DA + k]);
        for (int k = lane; k < DB; k += 64) s2 += bf2f(sb[(size_t)row * DB + k]) * bf2f(wb[(size_t)c * DB + k]);
        s1 = wave_sum(s1); s2 = wave_sum(s2);
        const float ga = 1.f / (1.f + expf(-bf2f(p[(size_t)row * NP + PC_GA + c]))), gb = 1.f / (1.f + expf(-bf2f(p[(size_t)row * NP + PC_GB + c])));
        const float m = ga * s1 + gb * s2, got = bf2f(mg[(size_t)row * D + c]);
        if (lane == 0 && !(fabsf(got - m) <= 0.01f + 0.03f * fabsf(m))) dbg_fail(P, 32u); }
}

#define XB_TMO      128
#define XB_XCNT(j)  (256  + 64 * (j))
#define XB_XSUB(j)  (1280 + 64 * (j))
#define XB_XGEN(j)  (2304 + 64 * (j))
#define XB_TOP      3328
#define XB_TOPGEN   3392
#define XCD_BAR_WORDS 3456
#define XB_SPIN_CAP (1u << 18)
__device__ __forceinline__ unsigned xb_ld(unsigned* p)              { return __hip_atomic_load(p, __ATOMIC_RELAXED, __HIP_MEMORY_SCOPE_AGENT); }
__device__ __forceinline__ unsigned xb_add(unsigned* p, unsigned v) { return __hip_atomic_fetch_add(p, v, __ATOMIC_RELAXED, __HIP_MEMORY_SCOPE_AGENT); }
__device__ __forceinline__ unsigned xb_xcc_id() { return (unsigned)__builtin_amdgcn_s_getreg((3 << 11) | 20) & 0xFu; }
#define XB_SPIN(cond, bar) do { unsigned _sp = 0; while (cond) { __builtin_amdgcn_s_sleep(1); \
    if ((++_sp & 255u) == 0u) { if (xb_ld(&(bar)[XB_TMO])) break; if (_sp > XB_SPIN_CAP) { atomicAdd(&(bar)[XB_TMO], 1u); break; } } } } while (0)
struct XcdBarrier { unsigned* bar; unsigned x; volatile LAS unsigned* st; };
__device__ __forceinline__ void xcd_barrier_complete(unsigned* bar, unsigned x, unsigned& nloc, unsigned& nx) {
    const unsigned G = gridDim.x * gridDim.y * gridDim.z;
    unsigned sum, cnt, mine, sp = 0u;
    for (;;) {
        sum = 0u; cnt = 0u; mine = 0u;
#pragma unroll
        for (unsigned j = 0; j < 16; ++j) { const unsigned c = xb_ld(&bar[XB_XCNT(j)]); sum += c; cnt += (c > 0u) ? 1u : 0u; mine = (j == x) ? c : mine; }
        if (sum == G) break;
        __builtin_amdgcn_s_sleep(1);
        if ((++sp & 255u) == 0u) { if (xb_ld(&bar[XB_TMO])) break; if (sp > XB_SPIN_CAP) { atomicAdd(&bar[XB_TMO], 1u); break; } }
    }
    nloc = mine > 0u ? mine : 1u; nx = cnt > 0u ? cnt : 1u;
}
__device__ __forceinline__ void xcd_barrier(const XcdBarrier& b) {
    asm volatile("s_waitcnt vmcnt(0)" ::: "memory");
    __syncthreads();
    if (threadIdx.x == 0) {
        unsigned* bar = b.bar;
        __builtin_amdgcn_s_waitcnt(0);
        unsigned nloc = b.st[0], nx = b.st[1];
        if (nloc == 0u) { xcd_barrier_complete(bar, b.x, nloc, nx); b.st[0] = nloc; b.st[1] = nx; }
        const unsigned old = xb_add(&bar[XB_XSUB(b.x)], 1u);
        const unsigned gen = old / nloc;
        if (old + 1u == (gen + 1u) * nloc) {
            __builtin_amdgcn_fence(__ATOMIC_RELEASE, "agent");
            asm volatile("s_waitcnt vmcnt(0)" ::: "memory");
            const unsigned og = xb_add(&bar[XB_TOP], 1u);
            const unsigned tg = og / nx;
            if (og + 1u == (tg + 1u) * nx) xb_add(&bar[XB_TOPGEN], 1u);
            else XB_SPIN(xb_ld(&bar[XB_TOPGEN]) == tg, bar);
            __builtin_amdgcn_fence(__ATOMIC_ACQUIRE, "agent");
            xb_add(&bar[XB_XGEN(b.x)], 1u);
            asm volatile("s_waitcnt vmcnt(0)" ::: "memory");
        } else {
            XB_SPIN(xb_ld(&bar[XB_XGEN(b.x)]) == gen, bar);
            __builtin_amdgcn_fence(__ATOMIC_ACQUIRE, "agent");
            asm volatile("s_waitcnt vmcnt(0)" ::: "memory");
        }
    }
    __syncthreads();
}
constexpr size_t WS_BAR = WS_END + 4096;
constexpr int LDS_XB = 131072;
#define LAUNDER(v) asm volatile("" : "+v"(v))
#if defined(__HIP_DEVICE_COMPILE__)
#define GETPARAMS const Params P = *Pp
#else
#define GETPARAMS const Params P = Pformal
#endif
__global__ void __launch_bounds__(512, 2) fwd_megakernel(Params Pformal) {
    extern __shared__ __attribute__((aligned(16))) unsigned char shm[];
    LAS unsigned char* lds = (LAS unsigned char*)shm;
    cg::grid_group grid = cg::this_grid();
    const int G = gridDim.x;
#if defined(__HIP_DEVICE_COMPILE__)
#define WS_PTR() (((const __attribute__((address_space(4))) Params*)__builtin_amdgcn_kernarg_segment_ptr())->ws)
#else
#define WS_PTR() (Pformal.ws)
#endif
#define GRID_BAR() do { XcdBarrier b_; b_.bar = (unsigned*)(WS_PTR() + WS_BAR); b_.x = xb_xcc_id(); b_.st = (volatile LAS unsigned*)(lds + LDS_XB); xcd_barrier(b_); } while (0)
    { unsigned* bar0 = (unsigned*)(WS_PTR() + WS_BAR); for (int i = blockIdx.x * 512 + threadIdx.x; i < XCD_BAR_WORDS; i += G * 512) bar0[i] = 0u;
      if (threadIdx.x == 0) { ((volatile LAS unsigned*)(lds + LDS_XB))[0] = 0u; ((volatile LAS unsigned*)(lds + LDS_XB))[1] = 0u; } }
#define TIDS() const __attribute__((address_space(4))) Params* Pp = (const __attribute__((address_space(4))) Params*)__builtin_amdgcn_kernarg_segment_ptr(); asm volatile("" : "+s"(Pp)); GETPARAMS; \
    bf16_t* hb = (bf16_t*)(P.ws + WS_HB); bf16_t* pbuf = (bf16_t*)(P.ws + WS_P); (void)hb; (void)pbuf; \
    int tid = threadIdx.x; LAUNDER(tid); const int wid = __builtin_amdgcn_readfirstlane(tid >> 6), lane = tid & 63; const int gw = blockIdx.x * 8 + wid, ngw = G * 8; (void)lane; (void)gw; (void)ngw
    { TIDS();
#ifdef DBG_CHECKS
      if (blockIdx.x == 0 && tid == 0) *(unsigned*)(P.ws + WS_DBG) = 0u;
#endif
      convert_small(P, lds, gw, ngw, wid, lane); }
    { TIDS(); convert_win(P, 0, lds, gw, ngw, wid, lane); }
    { TIDS(); embed_phase(P, gw, ngw, lane); }
    grid.sync();
    if (threadIdx.x == 0) (void)xb_add(&((unsigned*)(WS_PTR() + WS_BAR))[XB_XCNT(xb_xcc_id())], 1u);
    for (int l = 0; l < DEPTH; ++l) {
        {
            TIDS();
            pg8::Gemm g{hb, (const bf16_t*)(P.ws + WS_WIN), MPAD, NP, D}; pg8::StaticOrder S; S.init(MPAD, NP, G, blockIdx.x);
            EpiP E{pbuf}; pg8::gemm_run(lds, g, S, E, tid);
        }
        GRID_BAR();
#ifdef DBG_CHECKS
        if (l == 0) { TIDS(); chk_gemm1(P, gw, ngw, lane); }
#endif
        { TIDS(); p2_phase(P, l, (size_t)blockIdx.x * 512 + tid, (size_t)G * 512); }
        GRID_BAR();
        {
            TIDS();
            pg8::Gemm g{(const bf16_t*)(P.ws + WS_AL), (const bf16_t*)(P.ws + WS_WL) + (size_t)l * 4096 * 256, MPAD, 4096, 256}; pg8::StaticOrder S; S.init(MPAD, 4096, G, blockIdx.x);
            EpiLora E{(unsigned short*)(P.ws + WS_HB), (unsigned short*)(P.ws + WS_AB), P.w0 + (size_t)l * DB, P.a0 + (size_t)l * DB}; pg8::gemm_run(lds, g, S, E, tid);
        }
        GRID_BAR();
#ifdef DBG_CHECKS
        if (l == 0) { TIDS(); chk_lora(P, l, gw, ngw, lane); }
#endif
        { TIDS(); scan_phase(P, l, lds, tid); }
        GRID_BAR();
#ifdef DBG_CHECKS
        if (l == 0) { TIDS(); chk_scan(P, l, lds, gw, wid, lane); GRID_BAR(); }
#endif
        { TIDS(); p3b_phase(P, l, (size_t)blockIdx.x * 512 + tid, (size_t)G * 512); }
        if (l + 1 < DEPTH) { TIDS(); convert_win(P, l + 1, lds, gw, ngw, wid, lane); }
        GRID_BAR();
        {
            TIDS();
            pg8::StaticOrder S; S.init(NREAL, D, G, blockIdx.x);
            pg8::Gemm ga{(const bf16_t*)(P.ws + WS_CO), (const bf16_t*)(P.ws + WS_WA) + (size_t)l * D * DA, NREAL, D, DA};
            EpiY<false> Ea{hb, pbuf, PC_GA}; pg8::gemm_run(lds, ga, S, Ea, tid);
        }
        {
            TIDS();
            pg8::StaticOrder S; S.init(NREAL, D, G, blockIdx.x);
            pg8::Gemm gb{(const bf16_t*)(P.ws + WS_SB), (const bf16_t*)(P.ws + WS_WB) + (size_t)l * D * DB, NREAL, D, DB};
            EpiY<true> Eb{hb, pbuf, PC_GB}; pg8::gemm_run(lds, gb, S, Eb, tid);
        }
        { TIDS(); meta_p4(P, l, lds, wid, lane); }
        GRID_BAR();
#ifdef DBG_CHECKS
        if (l == 0) { TIDS(); chk_merged(P, l, gw, ngw, lane); }
#endif
        {
            TIDS();
            pg8::StaticOrder S; S.init(NREAL, D, G, blockIdx.x);
            pg8::Gemm g{hb, (const bf16_t*)(P.ws + WS_WO) + (size_t)l * D * D, NREAL, D, D};
            EpiOut E{(float*)(P.ws + WS_HF)}; pg8::gemm_run(lds, g, S, E, tid);
        }
        { TIDS(); meta_p5(P, l, lds, wid, lane); }
        GRID_BAR();
        { TIDS(); ln_phase(P, l, gw, ngw, lane); }
        if (l + 1 < DEPTH) GRID_BAR();
    }
#ifdef DBG_CHECKS
    GRID_BAR();
    { TIDS(); if (blockIdx.x == 0 && tid == 0) { const unsigned f = *(volatile unsigned*)(P.ws + WS_DBG); if (f) P.out[0] = 100.f * (float)(10 + f); } }
#endif
}

constexpr int LDS_BYTES = 131072 + 16;
extern "C" void kernel_launch(void* const* d_in, const int* in_sizes, int n_in, void* d_out, int out_size, void* d_ws, size_t ws_size, hipStream_t stream) {
    static int grid_blocks = 0;
    if (grid_blocks == 0) {
        if (n_in != 21 || ws_size < WS_BAR + 16384) { fprintf(stderr, "kernel_launch: unexpected n_in %d / ws_size %zu (need %zu)\n", n_in, ws_size, (size_t)WS_END); grid_blocks = -1; return; }
        int dev = 0, cus = 0, per_cu = 0;
        hipGetDevice(&dev); hipDeviceGetAttribute(&cus, hipDeviceAttributeMultiprocessorCount, dev);
        if (hipFuncSetAttribute((const void*)fwd_megakernel, hipFuncAttributeMaxDynamicSharedMemorySize, LDS_BYTES) != hipSuccess) fprintf(stderr, "kernel_launch: hipFuncSetAttribute failed\n");
        if (hipOccupancyMaxActiveBlocksPerMultiprocessor(&per_cu, (const void*)fwd_megakernel, 512, LDS_BYTES) != hipSuccess || per_cu < 1) { fprintf(stderr, "kernel_launch: occupancy query gave %d\n", per_cu); per_cu = 1; }
        (void)hipGetLastError();
        grid_blocks = cus * per_cu;
        if (grid_blocks > 256) grid_blocks = 256;
    }
    if (grid_blocks < 0) return;
    Params p{};
    const float** pp = (const float**)&p;
    for (int i = 0; i < 21; ++i) pp[i] = (const float*)d_in[i];
    p.out = (float*)d_out; p.ws = (unsigned char*)d_ws;
    void* args[] = {&p};
    hipError_t e = hipLaunchCooperativeKernel((const void*)fwd_megakernel, dim3(grid_blocks), dim3(512), args, LDS_BYTES, stream);
    if (e != hipSuccess) fprintf(stderr, "cooperative launch failed: %s (grid %d)\n", hipGetErrorString(e), grid_blocks);
}
```
